# Optimizing an MI355X kernel written in HIP

```python
import math
import jax, jax.numpy as jnp
from jax import lax
import numpy as np

D_MODEL = 1024
BATCH = 16
SEQ = 2048
DEPTH = 1

CHUNK = 64
N_META = 16
QBLOCK = 64
A_HEADS = 8
A_WIDTH = D_MODEL // 2
A_HEAD_DIM = A_WIDTH // A_HEADS
IDX_HEADS = 4
IDX_DIM = 64
TOPK_MAX = 256
B_HEADS = 4
B_WIDTH = D_MODEL - A_WIDTH
B_VAL_DIM = B_WIDTH // B_HEADS
B_KEY_DIM = B_VAL_DIM // 2
B_GATE_RANK = 16
B_GATE_TAU = 16.0
D_FF = 2816
CONV_W = 3
LN_EPS = 1e-5
RMS_EPS = 1e-6
ALPHA = (2.0 * DEPTH) ** 0.25
BETA = (8.0 * DEPTH) ** -0.25
IN_COLS = 3 * A_WIDTH + IDX_HEADS * IDX_DIM + IDX_DIM + IDX_HEADS + 2 * B_HEADS * B_KEY_DIM + 2 * B_WIDTH + B_GATE_RANK

kernel_name = "hymba_dsa_gla_deepnorm_convffn"


def _col_layout():
    return (('a_q', A_WIDTH, False), ('a_k', A_WIDTH, False), ('a_v', A_WIDTH, True),
            ('i_q', IDX_HEADS * IDX_DIM, False), ('i_k', IDX_DIM, False), ('i_w', IDX_HEADS, False),
            ('b_q', B_HEADS * B_KEY_DIM, False), ('b_k', B_HEADS * B_KEY_DIM, False), ('b_v', B_WIDTH, True),
            ('b_lr', B_GATE_RANK, False), ('b_og', B_WIDTH, False))


def _split_offsets():
    offs, acc = [], 0
    for _, n, _ in _col_layout()[:-1]:
        acc += n
        offs.append(acc)
    return offs


def layer_norm(x, g, b):
    xf = x.astype(jnp.float32)
    mu = jnp.mean(xf, axis=-1, keepdims=True)
    var = jnp.mean(jnp.square(xf - mu), axis=-1, keepdims=True)
    return ((xf - mu) * lax.rsqrt(var + LN_EPS) * g.astype(jnp.float32) + b.astype(jnp.float32)).astype(x.dtype)


def head_rms_norm(o, g):
    of = o.astype(jnp.float32)
    return (of * lax.rsqrt(jnp.mean(jnp.square(of), axis=-1, keepdims=True) + RMS_EPS) * g.astype(jnp.float32)).astype(o.dtype)


def chunk_ids(n):
    p = jnp.arange(n)
    return jnp.where(p < N_META, 0, 1 + (p - N_META) // CHUNK)


def alibi_slopes(n_heads):
    return jnp.asarray(2.0 ** (-8.0 * np.arange(1, n_heads + 1) / n_heads), dtype=jnp.float32)


def dsa_attention(q, k, v, qi, ki, wi, n_valid, topk):
    B, Tp, H, dh = q.shape
    nblk = Tp // QBLOCK
    pos = jnp.arange(Tp)
    cid = chunk_ids(Tp)
    key_ok = pos < n_valid
    slopes = alibi_slopes(H)
    kf = k.reshape(B, Tp, H * dh)
    vf = v.reshape(B, Tp, H * dh)
    kif = ki.astype(jnp.float32)

    def to_blocks(a):
        return a.reshape((B, nblk, QBLOCK) + a.shape[2:]).swapaxes(0, 1)

    def one_block(args):
        qb, qib, wib, tq = args
        cq = cid[tq]
        s = jnp.einsum('bqhd,bsd->bqhs', qib.astype(jnp.float32), kif)
        s = jnp.einsum('bqh,bqhs->bqs', wib.astype(jnp.float32), jax.nn.relu(s))
        allowed = (cid[None, :] <= cq[:, None]) & key_ok[None, :]
        s = jnp.where(allowed[None], s, -jnp.inf)
        _, idx = lax.top_k(s, topk)
        valid = (cid[idx] <= cq[None, :, None]) & (idx < n_valid)
        kg = jax.vmap(lambda a, i: a[i])(kf, idx).reshape(B, QBLOCK, topk, H, dh)
        vg = jax.vmap(lambda a, i: a[i])(vf, idx).reshape(B, QBLOCK, topk, H, dh)
        logits = jnp.einsum('bqhd,bqkhd->bqhk', qb, kg).astype(jnp.float32) * (dh ** -0.5)
        dist = jnp.abs(tq[None, :, None] - idx).astype(jnp.float32)
        logits = logits - slopes[None, None, :, None] * dist[:, :, None, :]
        logits = jnp.where(valid[:, :, None, :], logits, -jnp.inf)
        p = jax.nn.softmax(logits, axis=-1).astype(vg.dtype)
        return jnp.einsum('bqhk,bqkhd->bqhd', p, vg)

    out = lax.map(one_block, (to_blocks(q), to_blocks(qi), to_blocks(wi), pos.reshape(nblk, QBLOCK)))
    return out.swapaxes(0, 1).reshape(B, Tp, H, dh)


def gla_chunked(q, k, v, g):
    B, Tp, H, dk = q.shape
    dv = v.shape[-1]
    n = Tp // CHUNK

    def to_chunks(a):
        return a.astype(jnp.float32).reshape(B, n, CHUNK, H, a.shape[-1]).transpose(1, 0, 3, 2, 4)

    causal = jnp.tril(jnp.ones((CHUNK, CHUNK), dtype=bool))

    def step(S, inp):
        qc, kc, vc, gc = inp
        b = jnp.cumsum(gc, axis=2)
        o_inter = jnp.einsum('bhcd,bhde->bhce', qc * jnp.exp(b), S)
        diff = b[:, :, :, None, :] - b[:, :, None, :, :]
        decay = jnp.exp(jnp.where(causal[:, :, None], diff, -jnp.inf))
        A = jnp.einsum('bhid,bhjd,bhijd->bhij', qc, kc, decay)
        o_intra = jnp.einsum('bhij,bhje->bhie', A, vc)
        b_last = b[:, :, -1:, :]
        S = S * jnp.exp(b_last[:, :, 0, :])[..., None] + jnp.einsum('bhcd,bhce->bhde', kc * jnp.exp(b_last - b), vc)
        return S, o_inter + o_intra

    S0 = jnp.zeros((B, H, dk, dv), jnp.float32)
    _, o = lax.scan(step, S0, (to_chunks(q * (dk ** -0.5)), to_chunks(k), to_chunks(v), to_chunks(g)))
    return o.transpose(1, 0, 3, 2, 4).reshape(B, Tp, H, dv)


def conv_ffn(x, w_up, conv_w, conv_b, w_down):
    T = x.shape[1]
    a, gte = jnp.split(x @ w_up, 2, axis=-1)
    ap = jnp.pad(a, ((0, 0), (CONV_W - 1, 0), (0, 0)))
    a = sum(ap[:, j:j + T] * conv_w[j] for j in range(CONV_W)) + conv_b
    return (jax.nn.gelu(a) * gte) @ w_down


def setup_inputs(seed: int = 0) -> dict:
    key = jax.random.key(seed)
    ks = jax.random.split(key, 20)
    nrm = lambda k, shape: jax.random.normal(k, shape, jnp.float32)
    col_scale = jnp.concatenate([jnp.full((n,), BETA if is_v else 1.0, jnp.float32) for _, n, is_v in _col_layout()])
    return {
        'x': nrm(ks[0], (BATCH, SEQ, D_MODEL)),
        'meta': nrm(ks[1], (N_META, D_MODEL)),
        'ln_in_g': 1.0 + 0.01 * nrm(ks[2], (D_MODEL,)),
        'ln_in_b': 0.01 * nrm(ks[3], (D_MODEL,)),
        'w_in': nrm(ks[4], (DEPTH, D_MODEL, IN_COLS)) * (D_MODEL ** -0.5) * col_scale,
        'w_gate_b': nrm(ks[5], (DEPTH, B_GATE_RANK, B_HEADS * B_KEY_DIM)) * (B_GATE_RANK ** -0.5),
        'b_gate_b': 0.01 * nrm(ks[6], (DEPTH, B_HEADS * B_KEY_DIM)),
        'attn_norm_g': 1.0 + 0.01 * nrm(ks[7], (DEPTH, A_HEADS, A_HEAD_DIM)),
        'gla_norm_g': 1.0 + 0.01 * nrm(ks[8], (DEPTH, B_HEADS, B_VAL_DIM)),
        'w_out': nrm(ks[9], (DEPTH, D_MODEL, D_MODEL)) * (D_MODEL ** -0.5) * BETA,
        'ln1_g': 1.0 + 0.01 * nrm(ks[10], (DEPTH, D_MODEL)),
        'ln1_b': 0.01 * nrm(ks[11], (DEPTH, D_MODEL)),
        'w_up': nrm(ks[12], (DEPTH, D_MODEL, 2 * D_FF)) * (D_MODEL ** -0.5) * BETA,
        'conv_w': nrm(ks[13], (DEPTH, CONV_W, D_FF)) * (CONV_W ** -0.5),
        'conv_b': 0.01 * nrm(ks[14], (DEPTH, D_FF)),
        'w_down': nrm(ks[15], (DEPTH, D_FF, D_MODEL)) * (D_FF ** -0.5) * BETA,
        'ln2_g': 1.0 + 0.01 * nrm(ks[16], (DEPTH, D_MODEL)),
        'ln2_b': 0.01 * nrm(ks[17], (DEPTH, D_MODEL)),
    }


def reference(x, meta, ln_in_g, ln_in_b, w_in, w_gate_b, b_gate_b, attn_norm_g, gla_norm_g, w_out,
              ln1_g, ln1_b, w_up, conv_w, conv_b, w_down, ln2_g, ln2_b):
    B, S, D = x.shape
    T = N_META + S
    Tp = -(-T // QBLOCK) * QBLOCK
    topk = min(TOPK_MAX, S // 4)
    offs = _split_offsets()
    h = jnp.concatenate([jnp.broadcast_to(meta[None].astype(x.dtype), (B, N_META, D)), x], axis=1)
    h = layer_norm(h, ln_in_g, ln_in_b)
    for l in range(DEPTH):
        proj = jnp.pad(h @ w_in[l], ((0, 0), (0, Tp - T), (0, 0)))
        a_q, a_k, a_v, i_q, i_k, i_w, b_q, b_k, b_v, b_lr, b_og = jnp.split(proj, offs, axis=-1)
        a_out = dsa_attention(a_q.reshape(B, Tp, A_HEADS, A_HEAD_DIM),
                              a_k.reshape(B, Tp, A_HEADS, A_HEAD_DIM),
                              a_v.reshape(B, Tp, A_HEADS, A_HEAD_DIM),
                              i_q.reshape(B, Tp, IDX_HEADS, IDX_DIM), i_k,
                              i_w * (IDX_HEADS ** -0.5) * (IDX_DIM ** -0.5), T, topk)
        a_out = head_rms_norm(a_out, attn_norm_g[l]).reshape(B, Tp, A_WIDTH)
        log_g = jax.nn.log_sigmoid((b_lr @ w_gate_b[l] + b_gate_b[l]).astype(jnp.float32)) / B_GATE_TAU
        b_out = gla_chunked(b_q.reshape(B, Tp, B_HEADS, B_KEY_DIM), b_k.reshape(B, Tp, B_HEADS, B_KEY_DIM),
                            b_v.reshape(B, Tp, B_HEADS, B_VAL_DIM), log_g.reshape(B, Tp, B_HEADS, B_KEY_DIM))
        b_out = head_rms_norm(b_out.astype(x.dtype), gla_norm_g[l]).reshape(B, Tp, B_WIDTH) * jax.nn.silu(b_og)
        mixed = jnp.concatenate([a_out, b_out], axis=-1)[:, :T]
        h = layer_norm(ALPHA * h + mixed @ w_out[l], ln1_g[l], ln1_b[l])
        h = layer_norm(ALPHA * h + conv_ffn(h, w_up[l], conv_w[l], conv_b[l], w_down[l]), ln2_g[l], ln2_b[l])
    return h[:, N_META:]
```

```cpp
#include <hip/hip_runtime.h>
#include <cstdio>
#include <cstdint>

#define LAS __attribute__((address_space(3)))
#define GAS __attribute__((address_space(1)))
typedef unsigned short bf16_t;
typedef float f32x4 __attribute__((ext_vector_type(4)));
typedef unsigned u32x4 __attribute__((ext_vector_type(4)));
typedef unsigned long long u64;

constexpr int BATCH = 16, SEQ = 2048, DM = 1024, NMETA = 16;
constexpr int NTILE = 33, TP = NTILE * 64;
constexpr int MR = BATCH * SEQ;
constexpr int PC = 3584;
constexpr int C_AQ = 0, C_AK = 512, C_AV = 1024, C_IQ = 1536, C_IK = 1792, C_BQ = 1856, C_BK = 2112, C_BV = 2368, C_OG = 2880, C_LR = 3392, C_IW = 3408, C_END = 3412;
constexpr int DFF = 2816, NUP = 2 * DFF;
constexpr int TOPK = 256;
constexpr float ALPHA = 1.189207115002721f;
constexpr float LOG2E = 1.4426950408889634f;
constexpr float QSCALE = 0.125f * LOG2E;
constexpr int NWAVES = 8, NTHR = 512;

constexpr size_t MiB = 1u << 20;
constexpr size_t WS_CTL = 0, CTL_ZERO_BYTES = 1 * MiB;
constexpr size_t WS_H0M = 1 * MiB;
constexpr size_t WS_Y1M = WS_H0M + 65536;
constexpr size_t WS_H1M = WS_Y1M + 8192;
constexpr size_t WS_AMETA = WS_H1M + 8192;
constexpr size_t WS_MIXM = 2 * MiB;
constexpr size_t WS_WIN = 4 * MiB;
constexpr size_t WS_WOUT = 12 * MiB;
constexpr size_t WS_WUP = 14 * MiB;
constexpr size_t WS_WDN = 25 * MiB;
constexpr size_t WS_H0 = 32 * MiB;
constexpr size_t WS_H1 = 32 * MiB;
constexpr size_t WS_MASK = 96 * MiB;
constexpr size_t WS_MIXED = 112 * MiB;
constexpr size_t WS_PROJ = 176 * MiB;
constexpr size_t WS_Y1 = 176 * MiB;
constexpr size_t WS_U = 96 * MiB;
constexpr size_t WS_ACT = 272 * MiB;
constexpr size_t WS_Y2 = 96 * MiB;
constexpr size_t WS_IDX = 408 * MiB;
constexpr size_t WS_STAT = 3 * MiB;
constexpr size_t WS_FIX = 464 * MiB;
constexpr size_t WS_HALO = 470 * MiB;
constexpr size_t WS_END = 476 * MiB;
#ifndef PROBE_F32IDX
#define PROBE_F32IDX 0
#endif
constexpr int CW_BAR = 4096;
constexpr size_t WS_C12 = 64 * 1024;
constexpr size_t WS_ST1 = 128 * 1024;
constexpr size_t WS_ST2 = 512 * 1024;
constexpr size_t WS_Y1B = 176 * MiB;
constexpr size_t WS_Y2B = 96 * MiB;

__device__ __forceinline__ float bf2f(bf16_t v) { return __uint_as_float((unsigned)v << 16); }
__device__ __forceinline__ float bflo(unsigned u) { return __uint_as_float(u << 16); }
__device__ __forceinline__ float bfhi(unsigned u) { return __uint_as_float(u & 0xffff0000u); }
__device__ __forceinline__ unsigned f2bf(float f) { unsigned u = __float_as_uint(f); return (u + 0x7fffu + ((u >> 16) & 1u)) >> 16; }
__device__ __forceinline__ unsigned pk2(float lo, float hi) { return f2bf(lo) | (f2bf(hi) << 16); }
__device__ __forceinline__ float wave_sum(float v) {
#pragma unroll
    for (int o = 1; o < 64; o <<= 1) v += __shfl_xor(v, o);
    return v;
}
__device__ __forceinline__ float wave_max(float v) {
#pragma unroll
    for (int o = 1; o < 64; o <<= 1) v = fmaxf(v, __shfl_xor(v, o));
    return v;
}
#define LDS_WAIT() asm volatile("s_waitcnt lgkmcnt(0)" ::: "memory")

#define XB_TMO      128
#define XB_XCNT(j)  (256  + 64 * (j))
#define XB_XSUB(j)  (1280 + 64 * (j))
#define XB_XGEN(j)  (2304 + 64 * (j))
#define XB_TOP      3328
#define XB_TOPGEN   3392
#define XCD_BAR_WORDS 3456
#define XB_SPIN_CAP (1u << 22)
__device__ __forceinline__ unsigned xb_ld(unsigned* p)              { return __hip_atomic_load(p, __ATOMIC_RELAXED, __HIP_MEMORY_SCOPE_AGENT); }
__device__ __forceinline__ unsigned xb_add(unsigned* p, unsigned v) { return __hip_atomic_fetch_add(p, v, __ATOMIC_RELAXED, __HIP_MEMORY_SCOPE_AGENT); }
__device__ __forceinline__ unsigned xb_xcc_id() { return (unsigned)__builtin_amdgcn_s_getreg((3 << 11) | 20) & 0xFu; }
#define XB_SPIN(cond, bar) do { unsigned _sp = 0; while (cond) { __builtin_amdgcn_s_sleep(1); \
    if ((++_sp & 255u) == 0u) { if (xb_ld(&(bar)[XB_TMO])) break; if (_sp > XB_SPIN_CAP) { atomicAdd(&(bar)[XB_TMO], 1u); break; } } } } while (0)
struct XcdBarrier { unsigned* bar; unsigned x; volatile LAS unsigned* st; };
__device__ __forceinline__ XcdBarrier xcd_barrier_post(unsigned* bar, volatile LAS unsigned* st) {
    XcdBarrier b; b.bar = bar; b.x = xb_xcc_id(); b.st = st;
    if (threadIdx.x == 0) (void)xb_add(&bar[XB_XCNT(b.x)], 1u);
    return b;
}
__device__ __forceinline__ void xcd_barrier_complete(unsigned* bar, unsigned x, unsigned& nloc, unsigned& nx) {
    const unsigned G = gridDim.x * gridDim.y * gridDim.z;
    unsigned sum, cnt, mine, sp = 0u;
    for (;;) {
        sum = 0u; cnt = 0u; mine = 0u;
#pragma unroll
        for (unsigned j = 0; j < 16; ++j) { const unsigned c = xb_ld(&bar[XB_XCNT(j)]); sum += c; cnt += (c > 0u) ? 1u : 0u; mine = (j == x) ? c : mine; }
        if (sum == G) break;
        __builtin_amdgcn_s_sleep(1);
        if ((++sp & 255u) == 0u) { if (xb_ld(&bar[XB_TMO])) break; if (sp > XB_SPIN_CAP) { atomicAdd(&bar[XB_TMO], 1u); break; } }
    }
    nloc = mine > 0u ? mine : 1u; nx = cnt > 0u ? cnt : 1u;
}
__device__ __forceinline__ void xcd_barrier(const XcdBarrier& b) {
    asm volatile("s_waitcnt vmcnt(0)" ::: "memory");
    __syncthreads();
    if (threadIdx.x == 0) {
        unsigned* bar = b.bar;
        __builtin_amdgcn_s_waitcnt(0);
        unsigned nloc = b.st[0], nx = b.st[1];
        if (nloc == 0u) { xcd_barrier_complete(bar, b.x, nloc, nx); b.st[0] = nloc; b.st[1] = nx; }
        const unsigned old = xb_add(&bar[XB_XSUB(b.x)], 1u);
        const unsigned gen = old / nloc;
        if (old + 1u == (gen + 1u) * nloc) {
            __builtin_amdgcn_fence(__ATOMIC_RELEASE, "agent");
            asm volatile("s_waitcnt vmcnt(0)" ::: "memory");
            const unsigned og = xb_add(&bar[XB_TOP], 1u);
            const unsigned tg = og / nx;
            if (og + 1u == (tg + 1u) * nx) xb_add(&bar[XB_TOPGEN], 1u);
            else XB_SPIN(xb_ld(&bar[XB_TOPGEN]) == tg, bar);
            __builtin_amdgcn_fence(__ATOMIC_ACQUIRE, "agent");
            xb_add(&bar[XB_XGEN(b.x)], 1u);
            asm volatile("s_waitcnt vmcnt(0)" ::: "memory");
        } else {
            XB_SPIN(xb_ld(&bar[XB_XGEN(b.x)]) == gen, bar);
            __builtin_amdgcn_fence(__ATOMIC_ACQUIRE, "agent");
            asm volatile("s_waitcnt vmcnt(0)" ::: "memory");
        }
    }
    __syncthreads();
}

struct Args { const float* in[18]; float* out; unsigned char* ws; int ph_lo, ph_hi; };
struct Ctx {
    const Args* a;
    LAS unsigned char* lds;
    int tid, lane, wave, bid, G;
};
#define WSP(T, off) ((T*)(C.a->ws + (off)))
#define IN_(k) (C.a->in[k])

__device__ __forceinline__ int src_col_in(int n) {
    if (n < 1856) return n;
    if (n < 2880) return n + 4;
    if (n < 3392) return n + 20;
    if (n < 3408) return 2884 + (n - 3392);
    if (n < 3412) return 1856 + (n - 3408);
    return -1;
}
__device__ __forceinline__ int src_col_up(int n) { const int j = n >> 8, r = n & 255; return r < 128 ? 128 * j + r : DFF + 128 * j + (r - 128); }
template <int MAP> __device__ __forceinline__ void transpose_item(const float* W, int K, int Nsrc, int Ndst, bf16_t* WT, LAS float* scr, int item, int lane, const float* gam = nullptr, const float* bet = nullptr, float* c12 = nullptr) {
    const int nblk = Ndst / 32, kb = item / nblk, nb = item % nblk, k0 = 64 * kb, n0 = 32 * nb;
    const int nd = n0 + (lane & 31);
    const int sc = MAP == 1 ? src_col_in(nd) : (MAP == 2 ? src_col_up(nd) : nd);
    float s1 = 0.f, s2 = 0.f;
#pragma unroll 8
    for (int i = 0; i < 32; ++i) { const int kk = 2 * i + (lane >> 5); float w = sc >= 0 ? W[(size_t)(k0 + kk) * Nsrc + sc] : 0.f;
        if (MAP == 2 && gam) { s2 += bet[k0 + kk] * w; w *= gam[k0 + kk]; s1 += __uint_as_float(f2bf(w) << 16); }
        scr[kk * 33 + (lane & 31)] = w; }
    if (MAP == 2 && gam) { s1 += __shfl_xor(s1, 32); s2 += __shfl_xor(s2, 32); if (lane < 32) { atomicAdd(c12 + nd, s1); atomicAdd(c12 + NUP + nd, s2); } }
    LDS_WAIT(); asm volatile("" ::: "memory");
    const int c = lane & 7;
#pragma unroll
    for (int j = 0; j < 4; ++j) { const int n = (lane >> 3) + 8 * j; const LAS float* s = scr + (8 * c) * 33 + n;
        u32x4 o; o.x = pk2(s[0 * 33], s[1 * 33]); o.y = pk2(s[2 * 33], s[3 * 33]); o.z = pk2(s[4 * 33], s[5 * 33]); o.w = pk2(s[6 * 33], s[7 * 33]);
        *(u32x4*)(WT + (size_t)(n0 + n) * K + k0 + 8 * c) = o; }
    LDS_WAIT(); asm volatile("" ::: "memory");
}
template <bool OUT_BF16> __device__ __forceinline__ void ln_row(const float* xrow, const float* g, const float* bt, void* orow, int lane, float* stat = nullptr) {
    const f32x4* xr = (const f32x4*)xrow + lane;
    f32x4 v[4]; float s = 0.f;
#pragma unroll
    for (int j = 0; j < 4; ++j) { v[j] = xr[64 * j]; s += (v[j].x + v[j].y) + (v[j].z + v[j].w); }
    const float mean = wave_sum(s) * (1.f / DM); float s2 = 0.f;
#pragma unroll
    for (int j = 0; j < 4; ++j) { v[j] = v[j] - mean; s2 += (v[j].x * v[j].x + v[j].y * v[j].y) + (v[j].z * v[j].z + v[j].w * v[j].w); }
    const float rstd = 1.f / sqrtf(wave_sum(s2) * (1.f / DM) + 1e-5f);
    if (stat && lane == 0) { stat[0] = mean; stat[1] = rstd; }
#pragma unroll
    for (int j = 0; j < 4; ++j) {
        const f32x4 gg = ((const f32x4*)g)[lane + 64 * j], bb = ((const f32x4*)bt)[lane + 64 * j];
        const f32x4 o = v[j] * rstd * gg + bb;
        if (OUT_BF16) { u64 w = (u64)pk2(o.x, o.y) | ((u64)pk2(o.z, o.w) << 32); ((u64*)orow)[lane + 64 * j] = w; }
        else ((f32x4*)orow)[lane + 64 * j] = o;
    }
}
__device__ __forceinline__ void phase_prologue(Ctx& C) {
    LAS float* scr = (LAS float*)(C.lds + C.wave * 16384);
    const int gw = C.bid * NWAVES + C.wave, NGW = C.G * NWAVES;
    constexpr int I_IN = (DM / 64) * (PC / 32), I_OUT = (DM / 64) * (DM / 32), I_UP = (DM / 64) * (NUP / 32), I_DN = (DFF / 64) * (DM / 32);
    for (int it = gw; it < I_IN + I_OUT + I_UP + I_DN; it += NGW) {
        int r = it;
        if (r < I_IN) { transpose_item<1>(IN_(4), DM, C_END, PC, WSP(bf16_t, WS_WIN), scr, r, C.lane); continue; } r -= I_IN;
        if (r < I_OUT) { transpose_item<0>(IN_(9), DM, DM, DM, WSP(bf16_t, WS_WOUT), scr, r, C.lane); continue; } r -= I_OUT;
        if (r < I_UP) { transpose_item<2>(IN_(12), DM, NUP, NUP, WSP(bf16_t, WS_WUP), scr, r, C.lane); continue; } r -= I_UP;
        transpose_item<0>(IN_(15), DFF, DM, DM, WSP(bf16_t, WS_WDN), scr, r, C.lane);
    }
    for (int m = gw; m < MR + NMETA; m += NGW) {
        if (m < MR) ln_row<true>(IN_(0) + (size_t)m * DM, IN_(2), IN_(3), WSP(bf16_t, WS_H0) + (size_t)m * DM, C.lane, WSP(float, WS_STAT) + 2 * m);
        else ln_row<false>(IN_(1) + (size_t)(m - MR) * DM, IN_(2), IN_(3), WSP(float, WS_H0M) + (size_t)(m - MR) * DM, C.lane);
    }
}
__device__ __forceinline__ float proj_scale(int n) { return n < 512 ? QSCALE : ((n >= C_BQ && n < C_BK) ? 0.125f : 1.f); }
__device__ __forceinline__ void phase_meta(Ctx& C) {
    const int gw = C.bid * NWAVES + C.wave, NGW = C.G * NWAVES;
    for (int n = gw; n < PC; n += NGW) {
        const int sc = src_col_in(n);
        float acc[16];
#pragma unroll
        for (int p = 0; p < 16; ++p) acc[p] = 0.f;
        if (sc >= 0) {
            for (int k = C.lane; k < DM; k += 64) { const float w = IN_(4)[(size_t)k * C_END + sc];
#pragma unroll
                for (int p = 0; p < 16; ++p) acc[p] += WSP(float, WS_H0M)[p * DM + k] * w; }
        }
        float mine = 0.f;
#pragma unroll
        for (int p = 0; p < 16; ++p) { const float t = wave_sum(acc[p]); if (C.lane == p) mine = t; }
        if (C.lane < 16) { const bf16_t v = (bf16_t)f2bf(mine * proj_scale(n));
            for (int b = 0; b < BATCH; ++b) WSP(bf16_t, WS_PROJ)[((size_t)b * TP + 48 + C.lane) * PC + n] = v; }
    }
#if PROBE_F32IDX
    for (int n = gw; n < 324; n += NGW) {
        const int sc = n < 256 ? 1536 + n : (n < 320 ? 1792 + (n - 256) : 1856 + (n - 320));
        float acc[16];
#pragma unroll
        for (int p = 0; p < 16; ++p) acc[p] = 0.f;
        for (int k = C.lane; k < DM; k += 64) { const float w = IN_(4)[(size_t)k * C_END + sc];
#pragma unroll
            for (int p = 0; p < 16; ++p) acc[p] += WSP(float, WS_H0M)[p * DM + k] * w; }
        float mine = 0.f;
#pragma unroll
        for (int p = 0; p < 16; ++p) { const float t = wave_sum(acc[p]); if (C.lane == p) mine = t; }
        if (C.lane < 16) for (int b = 0; b < BATCH; ++b) WSP(float, WS_IDX)[((size_t)b * TP + 48 + C.lane) * 384 + n] = mine;
    }
#endif
    const int gt = C.bid * NTHR + C.tid, NGT = C.G * NTHR;
    for (int it = gt; it < BATCH * 48 * (PC / 8); it += NGT) {
        const int b = it / (48 * (PC / 8)), r = it % (48 * (PC / 8)), row = r / (PC / 8), c8 = r % (PC / 8);
        *(u32x4*)(WSP(bf16_t, WS_PROJ) + ((size_t)b * TP + row) * PC + c8 * 8) = (u32x4){0u, 0u, 0u, 0u};
    }
    for (int it = gt; it < BATCH * TP * NTILE; it += NGT) {
        const int t = it % NTILE, bi = it / NTILE, i = bi % TP, c = i >> 6;
        if (i < 256) { u64 w = 0ull; if (i >= 48) { if (t == 0) w = 0xFFFF000000000000ull; else if (t <= c) w = ~0ull; } WSP(u64, WS_MASK)[it] = w; }
        else if (t > c) WSP(u64, WS_MASK)[it] = 0ull;
    }
}

template <class Epi> __device__ __forceinline__ void naive_gemm(Ctx& C, const bf16_t* A, const bf16_t* Bt, int M, int N, int K, const Epi& epi) {
    LAS float* As = (LAS float*)C.lds; LAS float* Bs = As + 32 * 132;
    const int tn = N >> 7, ntile = (M >> 7) * tn, tid = C.tid;
    const int ty = tid >> 4, tx = tid & 15, lr = tid >> 2, lk = (tid & 3) * 8;
    for (int tile = C.bid; tile < ntile; tile += C.G) {
        const int m0 = (tile / tn) << 7, n0 = (tile % tn) << 7;
        float acc[4][8];
#pragma unroll
        for (int i = 0; i < 4; ++i)
#pragma unroll
            for (int j = 0; j < 8; ++j) acc[i][j] = 0.f;
        for (int k0 = 0; k0 < K; k0 += 32) {
            const u32x4 av = *(const u32x4*)(A + (size_t)(m0 + lr) * K + k0 + lk);
            const u32x4 bv = *(const u32x4*)(Bt + (size_t)(n0 + lr) * K + k0 + lk);
            __syncthreads();
            As[(lk + 0) * 132 + lr] = bflo(av.x); As[(lk + 1) * 132 + lr] = bfhi(av.x); As[(lk + 2) * 132 + lr] = bflo(av.y); As[(lk + 3) * 132 + lr] = bfhi(av.y);
            As[(lk + 4) * 132 + lr] = bflo(av.z); As[(lk + 5) * 132 + lr] = bfhi(av.z); As[(lk + 6) * 132 + lr] = bflo(av.w); As[(lk + 7) * 132 + lr] = bfhi(av.w);
            Bs[(lk + 0) * 132 + lr] = bflo(bv.x); Bs[(lk + 1) * 132 + lr] = bfhi(bv.x); Bs[(lk + 2) * 132 + lr] = bflo(bv.y); Bs[(lk + 3) * 132 + lr] = bfhi(bv.y);
            Bs[(lk + 4) * 132 + lr] = bflo(bv.z); Bs[(lk + 5) * 132 + lr] = bfhi(bv.z); Bs[(lk + 6) * 132 + lr] = bflo(bv.w); Bs[(lk + 7) * 132 + lr] = bfhi(bv.w);
            __syncthreads();
#pragma unroll 8
            for (int k = 0; k < 32; ++k) {
                const f32x4 a = *(const LAS f32x4*)(As + k * 132 + ty * 4);
                const f32x4 b0 = *(const LAS f32x4*)(Bs + k * 132 + tx * 8), b1 = *(const LAS f32x4*)(Bs + k * 132 + tx * 8 + 4);
#pragma unroll
                for (int i = 0; i < 4; ++i) { acc[i][0] += a[i] * b0[0]; acc[i][1] += a[i] * b0[1]; acc[i][2] += a[i] * b0[2]; acc[i][3] += a[i] * b0[3];
                                              acc[i][4] += a[i] * b1[0]; acc[i][5] += a[i] * b1[1]; acc[i][6] += a[i] * b1[2]; acc[i][7] += a[i] * b1[3]; }
            }
        }
#pragma unroll
        for (int i = 0; i < 4; ++i) epi(m0 + ty * 4 + i, n0 + tx * 8, acc[i]);
    }
    __syncthreads();
}
__device__ __forceinline__ void naive_idx_gemm(Ctx& C) {
    LAS float* As = (LAS float*)C.lds; LAS float* Bs = As + 32 * 132;
    const int tid = C.tid, ty = tid >> 4, tx = tid & 15, lr = tid >> 2, lk = (tid & 3) * 8, bk = tid >> 4, bn = (tid & 15) * 8;
    const float* X = IN_(0); const float* W = IN_(4); const float* G_ = IN_(2); const float* Bb = IN_(3);
    for (int tile = C.bid; tile < 256 * 3; tile += C.G) {
        const int m0 = (tile / 3) << 7, n0 = (tile % 3) << 7;
        float acc[4][8];
#pragma unroll
        for (int i = 0; i < 4; ++i)
#pragma unroll
            for (int j = 0; j < 8; ++j) acc[i][j] = 0.f;
        const float mean = WSP(float, WS_STAT)[2 * (m0 + lr)], rstd = WSP(float, WS_STAT)[2 * (m0 + lr) + 1];
        for (int k0 = 0; k0 < DM; k0 += 32) {
            const f32x4 x0 = *(const f32x4*)(X + (size_t)(m0 + lr) * DM + k0 + lk), x1 = *(const f32x4*)(X + (size_t)(m0 + lr) * DM + k0 + lk + 4);
            const f32x4 g0 = *(const f32x4*)(G_ + k0 + lk), g1 = *(const f32x4*)(G_ + k0 + lk + 4), b0 = *(const f32x4*)(Bb + k0 + lk), b1 = *(const f32x4*)(Bb + k0 + lk + 4);
            float bw[8];
#pragma unroll
            for (int j = 0; j < 8; ++j) { const int n = n0 + bn + j; const int sc = n < 256 ? 1536 + n : (n < 320 ? 1792 + (n - 256) : (n < 324 ? 1856 + (n - 320) : -1)); bw[j] = sc >= 0 ? W[(size_t)(k0 + bk) * C_END + sc] : 0.f; }
            __syncthreads();
            const f32x4 a0 = (x0 - mean) * rstd * g0 + b0, a1 = (x1 - mean) * rstd * g1 + b1;
            As[(lk + 0) * 132 + lr] = a0[0]; As[(lk + 1) * 132 + lr] = a0[1]; As[(lk + 2) * 132 + lr] = a0[2]; As[(lk + 3) * 132 + lr] = a0[3];
            As[(lk + 4) * 132 + lr] = a1[0]; As[(lk + 5) * 132 + lr] = a1[1]; As[(lk + 6) * 132 + lr] = a1[2]; As[(lk + 7) * 132 + lr] = a1[3];
#pragma unroll
            for (int j = 0; j < 8; ++j) Bs[bk * 132 + bn + j] = bw[j];
            __syncthreads();
#pragma unroll 8
            for (int k = 0; k < 32; ++k) {
                const f32x4 a = *(const LAS f32x4*)(As + k * 132 + ty * 4);
                const f32x4 c0 = *(const LAS f32x4*)(Bs + k * 132 + tx * 8), c1 = *(const LAS f32x4*)(Bs + k * 132 + tx * 8 + 4);
#pragma unroll
                for (int i = 0; i < 4; ++i) { acc[i][0] += a[i] * c0[0]; acc[i][1] += a[i] * c0[1]; acc[i][2] += a[i] * c0[2]; acc[i][3] += a[i] * c0[3];
                                              acc[i][4] += a[i] * c1[0]; acc[i][5] += a[i] * c1[1]; acc[i][6] += a[i] * c1[2]; acc[i][7] += a[i] * c1[3]; }
            }
        }
#pragma unroll
        for (int i = 0; i < 4; ++i) { const int m = m0 + ty * 4 + i, b = m >> 11, s_ = m & 2047; float* o = WSP(float, WS_IDX) + ((size_t)b * TP + 64 + s_) * 384 + n0 + tx * 8;
            ((f32x4*)o)[0] = (f32x4){acc[i][0], acc[i][1], acc[i][2], acc[i][3]}; ((f32x4*)o)[1] = (f32x4){acc[i][4], acc[i][5], acc[i][6], acc[i][7]}; }
    }
    __syncthreads();
}
__device__ __forceinline__ void store8_bf16(bf16_t* p, const float (&v)[8]) { u32x4 o; o.x = pk2(v[0], v[1]); o.y = pk2(v[2], v[3]); o.z = pk2(v[4], v[5]); o.w = pk2(v[6], v[7]); *(u32x4*)p = o; }
struct EpiProj { bf16_t* proj;
    __device__ __forceinline__ void operator()(int m, int n, const float (&v)[8]) const {
        const int b = m >> 11, s = m & 2047; const float sc = proj_scale(n); float w[8];
#pragma unroll
        for (int j = 0; j < 8; ++j) w[j] = v[j] * sc;
        store8_bf16(proj + ((size_t)b * TP + 64 + s) * PC + n, w); } };
struct EpiY { float* y; const bf16_t* res;
    __device__ __forceinline__ void operator()(int m, int n, const float (&v)[8]) const {
        const u32x4 r = *(const u32x4*)(res + (size_t)m * DM + n); float* o = y + (size_t)m * DM + n;
        ((f32x4*)o)[0] = (f32x4){ALPHA * bflo(r.x) + v[0], ALPHA * bfhi(r.x) + v[1], ALPHA * bflo(r.y) + v[2], ALPHA * bfhi(r.y) + v[3]};
        ((f32x4*)o)[1] = (f32x4){ALPHA * bflo(r.z) + v[4], ALPHA * bfhi(r.z) + v[5], ALPHA * bflo(r.w) + v[6], ALPHA * bfhi(r.w) + v[7]}; } };
struct EpiU { bf16_t* u;
    __device__ __forceinline__ void operator()(int m, int n, const float (&v)[8]) const { store8_bf16(u + (size_t)m * DFF + n, v); } };

namespace pg8 {
#define PG8_LAS __attribute__((address_space(3)))
typedef unsigned short bf16_t;
typedef short bf16x8 __attribute__((ext_vector_type(8)));
typedef float f32x4 __attribute__((ext_vector_type(4)));
typedef unsigned u32x4 __attribute__((ext_vector_type(4)));
constexpr int BM = 256, BK = 64, HALF = 128, HTB = HALF * BK * 2  , STAGE_BYTES = 8 * HTB, NXCD = 8, WGM = 8;

__host__ __device__ __forceinline__ int lds_byte(int r, int c) { const int st = (r >> 4) * 2 + (c >> 5), rr = r & 15, cc = c & 31, ob = rr * 64 + cc * 2; return st * 1024 + (ob ^ (((ob >> 9) & 1) << 5)); }
__host__ __device__ __forceinline__ void stage_rc(int b, int& R, int& C) { const int st = b / 1024, sb = b % 1024, swz = sb ^ (((sb >> 9) & 1) << 5); R = (st >> 1) * 16 + swz / 64; C = (st & 1) * 32 + (swz % 64) / 2; }
__host__ __device__ __forceinline__ int perm32(int rho) { const int n = rho >> 4, i = rho & 15; return 8 * (i >> 2) + 4 * n + (i & 3); }

struct Unit { int pm, pn; };
struct Gemm { const bf16_t* A; const bf16_t* Bt; int M, N, K; };

struct StaticOrder {
    int nM, nN, nwg, G, c;
    __host__ __device__ __forceinline__ void init(int M, int N, int G_, int c_) { nM = M / BM; nN = N / BM; nwg = nM * nN; G = G_; c = c_; }
    __host__ __device__ __forceinline__ bool next(int i, Unit& u) const {
        const long L = (long)i * G + c; if (L >= nwg) return false;
        int wgid = (int)L; { const int q = nwg / NXCD, r = nwg % NXCD, xcd = wgid % NXCD, off = wgid / NXCD; wgid = (xcd < r ? xcd * (q + 1) : r * (q + 1) + (xcd - r) * q) + off; }
        const int nig = WGM * nN, gid = wgid / nig, fm = gid * WGM, gsz = (nM - fm) < WGM ? (nM - fm) : WGM;
        u.pm = fm + ((wgid % nig) % gsz); u.pn = (wgid % nig) / gsz; return true;
    }
    __device__ __forceinline__ void a_ready(const Unit&) const {}
    __device__ __forceinline__ void done(const Unit&) const {}
};

__device__ __forceinline__ unsigned cvt_pk_bf16(float lo, float hi) { unsigned r; asm volatile("v_cvt_pk_bf16_f32 %0, %1, %2" : "=v"(r) : "v"(lo), "v"(hi)); return r; }
template <class Epi, class Sched, bool ALIGN_EPI = false, bool SP2 = false>
__device__ __forceinline__ void gemm_phase(PG8_LAS unsigned char* lds, const Gemm g, const Sched& S, const Epi& E) {
    const int tid = threadIdx.x, wid = __builtin_amdgcn_readfirstlane(tid >> 6), lane = tid & 63, wr = wid >> 2, wc = wid & 3, fr = lane & 15, fq = lane >> 4;
    const int K = g.K, nt = K / BK;
    unsigned voffA[2], voffB[2];
#pragma unroll
    for (int i = 0; i < 2; ++i) { int R, C; stage_rc(tid * 16 + i * 8192, R, C); const int Rb = Epi::PERM ? ((R & ~31) + perm32(R & 31)) : R;
        voffA[i] = (unsigned)(R * K + C) * 2u; voffB[i] = (unsigned)(Rb * K + C) * 2u; }
    const size_t kstep = (size_t)(BK * 2);
    const size_t hstep = (size_t)HALF * K * 2;
    const size_t tstep = 2 * hstep;
    const unsigned ldsw = (unsigned)wid * 1024u;
    const int aoff = lds_byte(wr * 64 + fr, fq * 8), boff = lds_byte(wc * 32 + fr, fq * 8);
#define PG8_SA(b, h) (((b) * 2 + (h)) * HTB)
#define PG8_SB(b, h) ((4 + (b) * 2 + (h)) * HTB)
#define PG8_STAGE(bufoff, gbase, voff) do { _Pragma("unroll") for (int _i = 0; _i < 2; ++_i) \
        __builtin_amdgcn_global_load_lds((const unsigned*)((const char*)(gbase) + (voff)[_i]), (PG8_LAS unsigned*)(lds + (bufoff) + ldsw + _i * 8192), 16, 0, 0); } while (0)
#define PG8_LDA(dst, b, h) do { _Pragma("unroll") for (int m = 0; m < 4; ++m) _Pragma("unroll") for (int k = 0; k < 2; ++k) dst[m][k] = *(const PG8_LAS bf16x8*)(lds + PG8_SA(b, h) + aoff + m * 2048 + k * 1024); } while (0)
#define PG8_LDB(dst, b, h) do { _Pragma("unroll") for (int n = 0; n < 2; ++n) _Pragma("unroll") for (int k = 0; k < 2; ++k) dst[n][k] = *(const PG8_LAS bf16x8*)(lds + PG8_SB(b, h) + boff + n * 2048 + k * 1024); } while (0)
#define PG8_MMA(ai, bj, At, Bt) do { __builtin_amdgcn_s_setprio(1); _Pragma("unroll") for (int m = 0; m < 4; ++m) _Pragma("unroll") for (int n = 0; n < 2; ++n) _Pragma("unroll") for (int k = 0; k < 2; ++k) \
        acc[ai][bj][m][n] = __builtin_amdgcn_mfma_f32_16x16x32_bf16(Bt[n][k], At[m][k], acc[ai][bj][m][n], 0, 0, 0); __builtin_amdgcn_s_setprio(0); } while (0)
#define PG8_WAIT_V(n) asm volatile("s_waitcnt vmcnt(" #n ")" ::: "memory")
#define PG8_WAIT_L(n) asm volatile("s_waitcnt lgkmcnt(" #n ")" ::: "memory")
#define PG8_BAR __builtin_amdgcn_s_barrier()
#define PG8_SCHED __builtin_amdgcn_sched_barrier(0)
    Unit cur, nxt; int ui = 0;
    if (!S.next(0, cur)) return;
    f32x4 acc[2][2][4][2];
#pragma unroll
    for (int a = 0; a < 2; ++a)
#pragma unroll
        for (int b = 0; b < 2; ++b)
#pragma unroll
            for (int m = 0; m < 4; ++m)
#pragma unroll
                for (int n = 0; n < 2; ++n) acc[a][b][m][n] = (f32x4){0.f, 0.f, 0.f, 0.f};
    bf16x8 At[4][2], B0[2][2], B1[2][2];
    const char* cA = (const char*)g.A + (size_t)cur.pm * tstep; const char* cB = (const char*)g.Bt + (size_t)cur.pn * tstep;
    S.a_ready(cur);
    if constexpr (SP2) {
        PG8_STAGE(PG8_SB(0, 0), cB, voffB); PG8_STAGE(PG8_SB(0, 1), cB + hstep, voffB); PG8_STAGE(PG8_SA(0, 0), cA, voffA); PG8_STAGE(PG8_SA(0, 1), cA + hstep, voffA);
        if (wr == 1) PG8_BAR;
        PG8_WAIT_V(2); PG8_BAR;
        PG8_STAGE(PG8_SB(1, 0), cB + kstep, voffB); PG8_STAGE(PG8_SA(1, 0), cA + kstep, voffA); PG8_STAGE(PG8_SB(1, 1), cB + hstep + kstep, voffB);
        PG8_WAIT_V(6); PG8_BAR;
    } else {
        PG8_STAGE(PG8_SB(0, 0), cB, voffB); PG8_STAGE(PG8_SA(0, 0), cA, voffA); PG8_STAGE(PG8_SB(0, 1), cB + hstep, voffB); PG8_STAGE(PG8_SA(0, 1), cA + hstep, voffA);
        if (wr == 1) PG8_BAR;
        PG8_WAIT_V(4); PG8_BAR;
        PG8_STAGE(PG8_SB(1, 0), cB + kstep, voffB); PG8_STAGE(PG8_SA(1, 0), cA + kstep, voffA); PG8_STAGE(PG8_SB(1, 1), cB + hstep + kstep, voffB);
        PG8_WAIT_V(6); PG8_BAR;
    }
    for (;;) {
        const bool has_next = S.next(ui + 1, nxt);
        const char* nA = has_next ? (const char*)g.A + (size_t)nxt.pm * tstep : cA; const char* nB = has_next ? (const char*)g.Bt + (size_t)nxt.pn * tstep : cB;
        for (int t = 0; t < nt; t += 2) {
            const bool last = (t == nt - 2);
            const char* a1 = cA + (size_t)(t + 1) * kstep;
            const char* a2 = last ? nA : cA + (size_t)(t + 2) * kstep; const char* b2 = last ? nB : cB + (size_t)(t + 2) * kstep;
            const char* a3 = a2 + kstep; const char* b3 = b2 + kstep;
            if (last && has_next) S.a_ready(nxt);
            if constexpr (SP2) {
            PG8_LDB(B0, 0, 0); PG8_LDB(B1, 0, 1); PG8_SCHED; PG8_LDA(At, 0, 0); PG8_STAGE(PG8_SA(1, 1), a1 + hstep, voffA);
            PG8_WAIT_V(8); PG8_WAIT_L(0); PG8_BAR; PG8_MMA(0, 0, At, B0); PG8_MMA(0, 1, At, B1); PG8_BAR; PG8_SCHED;
            PG8_LDA(At, 0, 1); PG8_STAGE(PG8_SB(0, 0), b2, voffB); PG8_STAGE(PG8_SB(0, 1), b2 + hstep, voffB); PG8_STAGE(PG8_SA(0, 0), a2, voffA);
            PG8_WAIT_V(8); PG8_WAIT_L(0); PG8_BAR; PG8_MMA(1, 0, At, B0); PG8_MMA(1, 1, At, B1); PG8_BAR; PG8_SCHED;
            PG8_LDB(B0, 1, 0); PG8_LDB(B1, 1, 1); PG8_SCHED; PG8_LDA(At, 1, 0); PG8_STAGE(PG8_SA(0, 1), a2 + hstep, voffA);
            PG8_WAIT_V(8); PG8_WAIT_L(0); PG8_BAR; PG8_MMA(0, 0, At, B0); PG8_MMA(0, 1, At, B1); PG8_BAR; PG8_SCHED;
            PG8_LDA(At, 1, 1); PG8_STAGE(PG8_SB(1, 0), b3, voffB); PG8_STAGE(PG8_SB(1, 1), b3 + hstep, voffB); PG8_STAGE(PG8_SA(1, 0), a3, voffA);
            PG8_WAIT_V(8); PG8_WAIT_L(0); PG8_BAR; PG8_MMA(1, 0, At, B0); PG8_MMA(1, 1, At, B1); PG8_BAR; PG8_SCHED;
            } else {
            PG8_LDB(B0, 0, 0); PG8_SCHED; PG8_LDA(At, 0, 0); PG8_STAGE(PG8_SA(1, 1), a1 + hstep, voffA);
            PG8_WAIT_L(8); PG8_BAR; PG8_WAIT_L(0); PG8_MMA(0, 0, At, B0); PG8_BAR; PG8_SCHED;
            PG8_LDB(B1, 0, 1); PG8_STAGE(PG8_SB(0, 0), b2, voffB);
            PG8_BAR; PG8_WAIT_L(0); PG8_MMA(0, 1, At, B1); PG8_BAR;
            PG8_LDA(At, 0, 1); PG8_STAGE(PG8_SA(0, 0), a2, voffA);
            PG8_BAR; PG8_WAIT_L(0); PG8_MMA(1, 0, At, B0); PG8_BAR; PG8_SCHED;
            PG8_STAGE(PG8_SB(0, 1), b2 + hstep, voffB);
            PG8_WAIT_V(6); PG8_BAR; PG8_MMA(1, 1, At, B1); PG8_BAR;
            PG8_LDB(B0, 1, 0); PG8_SCHED; PG8_LDA(At, 1, 0); PG8_STAGE(PG8_SA(0, 1), a2 + hstep, voffA);
            PG8_WAIT_L(8); PG8_BAR; PG8_WAIT_L(0); PG8_MMA(0, 0, At, B0); PG8_BAR; PG8_SCHED;
            PG8_LDB(B1, 1, 1); PG8_STAGE(PG8_SB(1, 0), b3, voffB);
            PG8_BAR; PG8_WAIT_L(0); PG8_MMA(0, 1, At, B1); PG8_BAR;
            PG8_LDA(At, 1, 1); PG8_STAGE(PG8_SA(1, 0), a3, voffA);
            PG8_BAR; PG8_WAIT_L(0); PG8_MMA(1, 0, At, B0); PG8_BAR; PG8_SCHED;
            PG8_STAGE(PG8_SB(1, 1), b3 + hstep, voffB);
            PG8_WAIT_V(6); PG8_BAR; PG8_MMA(1, 1, At, B1); PG8_BAR;
            }
        }
        if constexpr (ALIGN_EPI) { if (wr == 0) PG8_BAR; }
        if constexpr (!Epi::AFTER_DRAIN) { E(acc, cur, wr, wc, fr, fq); S.done(cur); }
        if (!has_next) break;
#pragma unroll
        for (int a = 0; a < 2; ++a)
#pragma unroll
            for (int b = 0; b < 2; ++b)
#pragma unroll
                for (int m = 0; m < 4; ++m)
#pragma unroll
                    for (int n = 0; n < 2; ++n) acc[a][b][m][n] = (f32x4){0.f, 0.f, 0.f, 0.f};
        cur = nxt; cA = nA; cB = nB; ++ui;
        if constexpr (ALIGN_EPI) { if (wr == 1) PG8_BAR; }
    }
    PG8_WAIT_V(0);
    if constexpr (!ALIGN_EPI) { if (wr == 0) PG8_BAR; }
    PG8_BAR;
    if constexpr (Epi::AFTER_DRAIN) { E.fused(acc, cur, wr, wc, fr, fq, lds, wid, lane); S.done(cur); }
#undef PG8_SA
#undef PG8_SB
#undef PG8_STAGE
#undef PG8_LDA
#undef PG8_LDB
#undef PG8_MMA
#undef PG8_WAIT_V
#undef PG8_WAIT_L
#undef PG8_BAR
#undef PG8_SCHED
}
}

template <class E> struct EpiAdapt {
    static constexpr bool PERM = true, AFTER_DRAIN = false;
    E e;
    __device__ __forceinline__ void operator()(const pg8::f32x4 (&acc)[2][2][4][2], const pg8::Unit& u, int wr, int wc, int fr, int fq) const {
#pragma unroll
        for (int ai = 0; ai < 2; ++ai)
#pragma unroll
            for (int m = 0; m < 4; ++m) { const int row = u.pm * 256 + ai * 128 + wr * 64 + m * 16 + fr;
#pragma unroll
                for (int bj = 0; bj < 2; ++bj) { const int col = u.pn * 256 + bj * 128 + wc * 32 + 8 * fq;
                    const float v[8] = {acc[ai][bj][m][0][0], acc[ai][bj][m][0][1], acc[ai][bj][m][0][2], acc[ai][bj][m][0][3], acc[ai][bj][m][1][0], acc[ai][bj][m][1][1], acc[ai][bj][m][1][2], acc[ai][bj][m][1][3]};
                    e(row, col, v); } }
    }
};
template <class E> __device__ __forceinline__ void fast_gemm(Ctx& C, const bf16_t* A, const bf16_t* Bt, int M, int N, int K, const E& e) {
    pg8::Gemm g{A, Bt, M, N, K}; pg8::StaticOrder S; S.init(M, N, C.G, C.bid);
    EpiAdapt<E> EA{e};
    pg8::gemm_phase<EpiAdapt<E>, pg8::StaticOrder, true, true>((PG8_LAS unsigned char*)C.lds, g, S, EA);
    __syncthreads();
}
#ifndef FAST_GEMM
#define FAST_GEMM 1
#endif
#if FAST_GEMM
#define GEMM_CALL fast_gemm
#else
#define GEMM_CALL naive_gemm
#endif


template <int MODE> struct EpiRowStats {
    static constexpr bool PERM = true, AFTER_DRAIN = false;
    bf16_t* y; float* stats; const bf16_t* res; const float* st1; const float* g1; const float* b1;
    __device__ __forceinline__ void operator()(const pg8::f32x4 (&acc)[2][2][4][2], const pg8::Unit& u, int wr, int wc, int fr, int fq) const {
#pragma unroll
        for (int ai = 0; ai < 2; ++ai)
#pragma unroll
            for (int m = 0; m < 4; ++m) { const int row = u.pm * 256 + ai * 128 + wr * 64 + m * 16 + fr; float sm = 0.f, sq = 0.f;
                float mean1 = 0.f, rstd1 = 0.f;
                if (MODE == 1) { const float a = st1[2 * row], b = st1[2 * row + 1]; mean1 = a * (1.f / DM); rstd1 = 1.f / sqrtf(fmaxf(b * (1.f / DM) - mean1 * mean1, 0.f) + 1e-5f); }
#pragma unroll
                for (int bj = 0; bj < 2; ++bj) { const int col = u.pn * 256 + bj * 128 + wc * 32 + 8 * fq;
                    const u32x4 r8 = *(const u32x4*)(res + (size_t)row * DM + col);
                    float rv[8] = {bflo(r8.x), bfhi(r8.x), bflo(r8.y), bfhi(r8.y), bflo(r8.z), bfhi(r8.z), bflo(r8.w), bfhi(r8.w)};
                    if (MODE == 1) { const f32x4 ga = *(const f32x4*)(g1 + col), gb = *(const f32x4*)(g1 + col + 4), ba = *(const f32x4*)(b1 + col), bb = *(const f32x4*)(b1 + col + 4);
                        const float gg[8] = {ga[0], ga[1], ga[2], ga[3], gb[0], gb[1], gb[2], gb[3]}, be[8] = {ba[0], ba[1], ba[2], ba[3], bb[0], bb[1], bb[2], bb[3]};
#pragma unroll
                        for (int j = 0; j < 8; ++j) rv[j] = (rv[j] - mean1) * rstd1 * gg[j] + be[j]; }
                    float v[8];
#pragma unroll
                    for (int j = 0; j < 8; ++j) { v[j] = ALPHA * rv[j] + acc[ai][bj][m][j >> 2][j & 3]; sm += v[j]; sq += v[j] * v[j]; }
                    store8_bf16(y + (size_t)row * DM + col, v); }
                sm += __shfl_xor(sm, 16); sm += __shfl_xor(sm, 32); sq += __shfl_xor(sq, 16); sq += __shfl_xor(sq, 32);
                if (fq == 0) { atomicAdd(stats + 2 * row, sm); atomicAdd(stats + 2 * row + 1, sq); } }
    }
};
__device__ __forceinline__ void ln2_row(const bf16_t* yrow, const float* st, const float* g, const float* bt, float* orow, int lane) {
    const float mean = st[0] * (1.f / DM), rstd = 1.f / sqrtf(fmaxf(st[1] * (1.f / DM) - mean * mean, 0.f) + 1e-5f);
#pragma unroll
    for (int j = 0; j < 2; ++j) { const int c0 = j * 512 + lane * 8; const u32x4 r8 = *(const u32x4*)(yrow + c0);
        const float v[8] = {bflo(r8.x), bfhi(r8.x), bflo(r8.y), bfhi(r8.y), bflo(r8.z), bfhi(r8.z), bflo(r8.w), bfhi(r8.w)};
        const f32x4 ga = *(const f32x4*)(g + c0), gb = *(const f32x4*)(g + c0 + 4), ba = *(const f32x4*)(bt + c0), bb = *(const f32x4*)(bt + c0 + 4);
        *(f32x4*)(orow + c0) = (f32x4){(v[0] - mean) * rstd * ga[0] + ba[0], (v[1] - mean) * rstd * ga[1] + ba[1], (v[2] - mean) * rstd * ga[2] + ba[2], (v[3] - mean) * rstd * ga[3] + ba[3]};
        *(f32x4*)(orow + c0 + 4) = (f32x4){(v[4] - mean) * rstd * gb[0] + bb[0], (v[5] - mean) * rstd * gb[1] + bb[1], (v[6] - mean) * rstd * gb[2] + bb[2], (v[7] - mean) * rstd * gb[3] + bb[3]}; }
}
__device__ __forceinline__ void job_y1m_fast(Ctx& C) {
    const int gw = C.bid * NWAVES + C.wave, NGW = C.G * NWAVES;
    for (int o = gw; o < 2 * DM; o += NGW) { const int r = o >> 10, n = o & 1023; const bf16_t* mr = WSP(bf16_t, WS_MIXM) + (size_t)(14 + r) * DM; const bf16_t* wr_ = WSP(bf16_t, WS_WOUT) + (size_t)n * DM; float acc = 0.f;
#pragma unroll
        for (int j = 0; j < 2; ++j) { const int k0 = j * 512 + C.lane * 8; const u32x4 a = *(const u32x4*)(mr + k0), w = *(const u32x4*)(wr_ + k0);
            acc += bflo(a.x) * bflo(w.x) + bfhi(a.x) * bfhi(w.x) + bflo(a.y) * bflo(w.y) + bfhi(a.y) * bfhi(w.y) + bflo(a.z) * bflo(w.z) + bfhi(a.z) * bfhi(w.z) + bflo(a.w) * bflo(w.w) + bfhi(a.w) * bfhi(w.w); }
        acc = wave_sum(acc);
        if (C.lane == 0) WSP(float, WS_Y1M)[r * DM + n] = ALPHA * WSP(float, WS_H0M)[(14 + r) * DM + n] + acc; }
}
__device__ __forceinline__ void job_ameta_fast(Ctx& C) {
    const int gw = C.bid * NWAVES + C.wave, NGW = C.G * NWAVES;
    for (int n = gw; n < DFF; n += NGW) { const int nr = (n >> 7) * 256 + (n & 127); const bf16_t* wr_ = WSP(bf16_t, WS_WUP) + (size_t)nr * DM; const float* y = WSP(float, WS_Y1M);
        float d0 = 0.f, d1 = 0.f, s0 = 0.f, s1 = 0.f, q0 = 0.f, q1 = 0.f;
#pragma unroll
        for (int j = 0; j < 2; ++j) { const int k0 = j * 512 + C.lane * 8; const u32x4 w = *(const u32x4*)(wr_ + k0);
            const float wv[8] = {bflo(w.x), bfhi(w.x), bflo(w.y), bfhi(w.y), bflo(w.z), bfhi(w.z), bflo(w.w), bfhi(w.w)};
#pragma unroll
            for (int e = 0; e < 8; ++e) { const float a = y[k0 + e], b = y[DM + k0 + e]; d0 += a * wv[e]; d1 += b * wv[e]; s0 += a; s1 += b; q0 += a * a; q1 += b * b; } }
        d0 = wave_sum(d0); d1 = wave_sum(d1); s0 = wave_sum(s0); s1 = wave_sum(s1); q0 = wave_sum(q0); q1 = wave_sum(q1);
        if (C.lane == 0) { const float c1 = WSP(float, WS_C12)[nr], c2 = WSP(float, WS_C12)[NUP + nr];
            const float m0 = s0 * (1.f / DM), m1 = s1 * (1.f / DM), r0 = 1.f / sqrtf(fmaxf(q0 * (1.f / DM) - m0 * m0, 0.f) + 1e-5f), r1 = 1.f / sqrtf(fmaxf(q1 * (1.f / DM) - m1 * m1, 0.f) + 1e-5f);
            WSP(float, WS_AMETA)[n] = r0 * (d0 - m0 * c1) + c2; WSP(float, WS_AMETA)[DFF + n] = r1 * (d1 - m1 * c1) + c2; } }
}
#ifndef FUSE_LN
#define FUSE_LN 1
#endif

struct EpiYB { bf16_t* y; const bf16_t* res;
    __device__ __forceinline__ void operator()(int m, int n, const float (&v)[8]) const {
        const u32x4 r = *(const u32x4*)(res + (size_t)m * DM + n);
        const float w[8] = {ALPHA * bflo(r.x) + v[0], ALPHA * bfhi(r.x) + v[1], ALPHA * bflo(r.y) + v[2], ALPHA * bfhi(r.y) + v[3], ALPHA * bflo(r.z) + v[4], ALPHA * bfhi(r.z) + v[5], ALPHA * bflo(r.w) + v[6], ALPHA * bfhi(r.w) + v[7]};
        store8_bf16(y + (size_t)m * DM + n, w); } };
template <bool OUT_BF16> __device__ __forceinline__ void ln_row_b(const bf16_t* yrow, const float* g, const float* bt, void* orow, int lane) {
    float v[16]; float sm = 0.f;
#pragma unroll
    for (int j = 0; j < 2; ++j) { const u32x4 r8 = *(const u32x4*)(yrow + j * 512 + lane * 8);
        v[8 * j] = bflo(r8.x); v[8 * j + 1] = bfhi(r8.x); v[8 * j + 2] = bflo(r8.y); v[8 * j + 3] = bfhi(r8.y); v[8 * j + 4] = bflo(r8.z); v[8 * j + 5] = bfhi(r8.z); v[8 * j + 6] = bflo(r8.w); v[8 * j + 7] = bfhi(r8.w); }
#pragma unroll
    for (int e = 0; e < 16; ++e) sm += v[e];
    const float mean = wave_sum(sm) * (1.f / DM); float sq = 0.f;
#pragma unroll
    for (int e = 0; e < 16; ++e) { v[e] -= mean; sq += v[e] * v[e]; }
    const float rstd = 1.f / sqrtf(wave_sum(sq) * (1.f / DM) + 1e-5f);
#pragma unroll
    for (int j = 0; j < 2; ++j) { const int c0 = j * 512 + lane * 8;
        const f32x4 ga = *(const f32x4*)(g + c0), gb = *(const f32x4*)(g + c0 + 4), ba = *(const f32x4*)(bt + c0), bb = *(const f32x4*)(bt + c0 + 4);
        const float o[8] = {v[8 * j] * rstd * ga[0] + ba[0], v[8 * j + 1] * rstd * ga[1] + ba[1], v[8 * j + 2] * rstd * ga[2] + ba[2], v[8 * j + 3] * rstd * ga[3] + ba[3],
                            v[8 * j + 4] * rstd * gb[0] + bb[0], v[8 * j + 5] * rstd * gb[1] + bb[1], v[8 * j + 6] * rstd * gb[2] + bb[2], v[8 * j + 7] * rstd * gb[3] + bb[3]};
        if (OUT_BF16) store8_bf16((bf16_t*)orow + c0, o);
        else { *(f32x4*)((float*)orow + c0) = (f32x4){o[0], o[1], o[2], o[3]}; *(f32x4*)((float*)orow + c0 + 4) = (f32x4){o[4], o[5], o[6], o[7]}; } }
}
__device__ __forceinline__ void job_ameta_fast2(Ctx& C) {
    const int gw = C.bid * NWAVES + C.wave, NGW = C.G * NWAVES;
    for (int n = gw; n < DFF; n += NGW) { const int nr = (n >> 7) * 256 + (n & 127); const bf16_t* wr_ = WSP(bf16_t, WS_WUP) + (size_t)nr * DM; const float* y = WSP(float, WS_H1M);
        float d0 = 0.f, d1 = 0.f;
#pragma unroll
        for (int j = 0; j < 2; ++j) { const int k0 = j * 512 + C.lane * 8; const u32x4 w = *(const u32x4*)(wr_ + k0);
            const float wv[8] = {bflo(w.x), bfhi(w.x), bflo(w.y), bfhi(w.y), bflo(w.z), bfhi(w.z), bflo(w.w), bfhi(w.w)};
#pragma unroll
            for (int e = 0; e < 8; ++e) { d0 += y[k0 + e] * wv[e]; d1 += y[DM + k0 + e] * wv[e]; } }
        d0 = wave_sum(d0); d1 = wave_sum(d1);
        if (C.lane == 0) { WSP(float, WS_AMETA)[n] = d0; WSP(float, WS_AMETA)[DFF + n] = d1; } }
}
__device__ __forceinline__ float gelu_fast(float x) { const float u = x * (0.7978845608028654f + 0.035677408136300125f * x * x); return x * __builtin_amdgcn_rcpf(1.f + __builtin_amdgcn_exp2f(-2.f * LOG2E * u)); }
__device__ __forceinline__ float dpp_prev(float xp, float x, int which) {
    const int xi = __float_as_int(x), pi = __float_as_int(xp);
    if (which == 1) { const int o = __builtin_amdgcn_update_dpp(0, pi, 0x121, 0xf, 0xf, true); return __int_as_float(__builtin_amdgcn_update_dpp(o, xi, 0x111, 0xf, 0xf, false)); }
    const int o = __builtin_amdgcn_update_dpp(0, pi, 0x122, 0xf, 0xf, true); return __int_as_float(__builtin_amdgcn_update_dpp(o, xi, 0x112, 0xf, 0xf, false));
}
struct EpiUpConv {
    static constexpr bool PERM = true, AFTER_DRAIN = false;
    bf16_t* act; float* fix; float* halo; const float* cw; const float* cb; LAS float* xch; const float* st1; const float* c12;
    __device__ __forceinline__ void operator()(const pg8::f32x4 (&acc_in)[2][2][4][2], const pg8::Unit& u, int wr, int wc, int fr, int fq) const {
        const int cl = wc * 32 + 8 * fq, hc = u.pn * 128 + cl, un = u.pm * 22 + u.pn;
        pg8::f32x4 (&acc)[2][2][4][2] = const_cast<pg8::f32x4 (&)[2][2][4][2]>(acc_in);
        asm volatile("" ::: "memory");
        float w0[8], w1[8], w2[8], bb[8];
#pragma unroll
        for (int j = 0; j < 8; ++j) { w0[j] = cw[hc + j]; w1[j] = cw[DFF + hc + j]; w2[j] = cw[2 * DFF + hc + j]; bb[j] = cb[hc + j]; }
        if (fr >= 14) {
#pragma unroll
            for (int ai = 0; ai < 2; ++ai) { LAS float* xr = xch + ((ai * 2 + wr) * 2 + (fr - 14)) * 128 + cl;
                *(LAS f32x4*)xr = acc[ai][0][3][0]; *(LAS f32x4*)(xr + 4) = acc[ai][0][3][1]; }
            if (wr == 1) { float* hr = halo + ((size_t)un * 2 + (fr - 14)) * 128 + cl; *(f32x4*)hr = acc[1][0][3][0]; *(f32x4*)(hr + 4) = acc[1][0][3][1]; }
        }
        asm volatile("s_waitcnt lgkmcnt(0)\n\ts_barrier" ::: "memory");
#pragma unroll
        for (int ai = 0; ai < 2; ++ai) {
            float xp[8];
            { const int sb = (wr == 1) ? ai * 2 : 1;
              const LAS float* xr = xch + (sb * 2 + (fr & 1)) * 128 + cl; const f32x4 t0 = *(const LAS f32x4*)xr, t1 = *(const LAS f32x4*)(xr + 4);
              xp[0] = t0[0]; xp[1] = t0[1]; xp[2] = t0[2]; xp[3] = t0[3]; xp[4] = t1[0]; xp[5] = t1[1]; xp[6] = t1[2]; xp[7] = t1[3]; }
#pragma unroll
            for (int m = 0; m < 4; ++m) {
                float o[8];
#pragma unroll
                for (int j = 0; j < 8; ++j) { const float x = acc[ai][0][m][j >> 2][j & 3]; const float p = (m == 0) ? xp[j] : acc[ai][0][m > 0 ? m - 1 : 0][j >> 2][j & 3];
                    const float a1 = dpp_prev(p, x, 1), a2 = dpp_prev(p, x, 2);
                    o[j] = gelu_fast(a2 * w0[j] + a1 * w1[j] + x * w2[j] + bb[j]) * acc[ai][1][m][j >> 2][j & 3]; }
                const int row = u.pm * 256 + ai * 128 + wr * 64 + m * 16 + fr;
                if (ai == 0 && wr == 0 && m == 0 && fr < 2) {
                    float* fx = fix + ((size_t)un * 2 + fr) * 256 + cl;
                    *(f32x4*)fx = acc[0][0][0][0]; *(f32x4*)(fx + 4) = acc[0][0][0][1]; *(f32x4*)(fx + 128) = acc[0][1][0][0]; *(f32x4*)(fx + 132) = acc[0][1][0][1];
                } else store8_bf16(act + (size_t)row * DFF + hc, o);
            }
        }
        asm volatile("s_waitcnt lgkmcnt(0)\n\ts_barrier" ::: "memory");
    }
};
__device__ __forceinline__ void fix_rows(Ctx& C, int pm) {
    const float* fix = WSP(float, WS_FIX); const float* halo = WSP(float, WS_HALO); const float* am = WSP(float, WS_AMETA); const float* cw = IN_(13); const float* cb = IN_(14);
    for (int e = C.tid; e < 2 * DFF; e += NTHR) {
        const int r = e / DFF, hc = e % DFF, pn = hc >> 7, cl = hc & 127, un = pm * 22 + pn;
        const float a0 = fix[((size_t)un * 2 + r) * 256 + cl], g0 = fix[((size_t)un * 2 + r) * 256 + 128 + cl];
        float a1, a2;
        if ((pm & 7) == 0) { a1 = (r == 0) ? am[DFF + hc] : fix[((size_t)un * 2) * 256 + cl]; a2 = (r == 0) ? am[hc] : am[DFF + hc]; }
        else { const float* h = halo + ((size_t)(un - 22) * 2) * 128 + cl; a1 = (r == 0) ? h[128] : fix[((size_t)un * 2) * 256 + cl]; a2 = (r == 0) ? h[0] : h[128]; }
        const float cv = a2 * cw[hc] + a1 * cw[DFF + hc] + a0 * cw[2 * DFF + hc] + cb[hc];
        WSP(bf16_t, WS_ACT)[(size_t)(pm * 256 + r) * DFF + hc] = (bf16_t)f2bf(gelu_fast(cv) * g0);
    }
}
#ifndef FUSE_CONV
#define FUSE_CONV 1
#endif
__device__ __forceinline__ unsigned sortable(float f) { const unsigned u = __float_as_uint(f); return (u & 0x80000000u) ? ~u : (u | 0x80000000u); }
__device__ __forceinline__ void phase_select_naive(Ctx& C) {
    LAS float* qs = (LAS float*)C.lds;
    LAS unsigned* keys = (LAS unsigned*)(C.lds + 2048);
    LAS unsigned* cntw = (LAS unsigned*)(C.lds + 2048 + 2112 * 4);
    const int tid = C.tid, lane = C.lane, wave = C.wave;
    const int NQ = BATCH * (NTILE - 4) * 64;
    for (int q = C.bid; q < NQ; q += C.G) {
        const int b = q / ((NTILE - 4) * 64), i = 256 + q % ((NTILE - 4) * 64), c = i >> 6, n = 64 * (c + 1);
        const bf16_t* qrow = WSP(bf16_t, WS_PROJ) + ((size_t)b * TP + i) * PC;
        __syncthreads();
#if PROBE_F32IDX
        { const float* qf = WSP(float, WS_IDX) + ((size_t)b * TP + i) * 384; if (tid < 256) qs[tid] = qf[tid]; else if (tid < 260) qs[tid] = qf[320 + tid - 256]; }
#else
        if (tid < 256) qs[tid] = bf2f(qrow[C_IQ + tid]); else if (tid < 260) qs[tid] = bf2f(qrow[C_IW + tid - 256]);
#endif
        if (tid < 8) cntw[tid] = 0u;
        __syncthreads();
#pragma unroll 1
        for (int e = tid; e < n; e += NTHR) {
            asm volatile("" ::: "memory");
            const u32x4* kp = (const u32x4*)(WSP(bf16_t, WS_PROJ) + ((size_t)b * TP + e) * PC + C_IK);
            float d0 = 0.f, d1 = 0.f, d2 = 0.f, d3 = 0.f;
#pragma unroll
            for (int j = 0; j < 8; ++j) { float kv[8];
#if PROBE_F32IDX
                { const f32x4* kf = (const f32x4*)(WSP(float, WS_IDX) + ((size_t)b * TP + e) * 384 + 256 + 8 * j); const f32x4 t0 = kf[0], t1 = kf[1];
                  kv[0] = t0[0]; kv[1] = t0[1]; kv[2] = t0[2]; kv[3] = t0[3]; kv[4] = t1[0]; kv[5] = t1[1]; kv[6] = t1[2]; kv[7] = t1[3]; }
#else
                const u32x4 t = kp[j]; kv[0] = bflo(t.x); kv[1] = bfhi(t.x); kv[2] = bflo(t.y); kv[3] = bfhi(t.y);
                kv[4] = bflo(t.z); kv[5] = bfhi(t.z); kv[6] = bflo(t.w); kv[7] = bfhi(t.w);
#endif
#pragma unroll
                for (int e2 = 0; e2 < 8; ++e2) { d0 += qs[8 * j + e2] * kv[e2]; d1 += qs[64 + 8 * j + e2] * kv[e2]; d2 += qs[128 + 8 * j + e2] * kv[e2]; d3 += qs[192 + 8 * j + e2] * kv[e2]; } }
            float sc = qs[256] * fmaxf(d0, 0.f) + qs[257] * fmaxf(d1, 0.f) + qs[258] * fmaxf(d2, 0.f) + qs[259] * fmaxf(d3, 0.f);
            sc = sc + 0.f;
            if (e < 48) sc = -INFINITY;
            keys[e] = sortable(sc);
        }
        __syncthreads();
        unsigned prefix = 0u;
        for (int bit = 31; bit >= 0; --bit) {
            const unsigned t = prefix | (1u << bit);
            unsigned my = 0u;
            for (int e = tid; e < n; e += NTHR) my += (keys[e] >= t) ? 1u : 0u;
            my = (unsigned)wave_sum((float)my);
            if (lane == 0 && my) atomicAdd((unsigned*)&cntw[bit & 1], my);
            __syncthreads();
            const unsigned tot = cntw[bit & 1];
            if (tid == 0) cntw[(bit & 1) ^ 1] = 0u;
            if (tot >= (unsigned)TOPK) prefix = t;
            __syncthreads();
        }
        {
            unsigned my = 0u;
            for (int e = tid; e < n; e += NTHR) my += (keys[e] >= prefix) ? 1u : 0u;
            my = (unsigned)wave_sum((float)my);
            if (tid == 0) { cntw[2] = 0u; }
            __syncthreads();
            if (lane == 0 && my) atomicAdd((unsigned*)&cntw[2], my);
            __syncthreads();
            const unsigned ge = cntw[2];
            if (ge != (unsigned)TOPK && tid == 0) {
                int drop = (int)ge - TOPK;
                for (int e = n - 1; e >= 0 && drop > 0; --e) if (keys[e] == prefix) { keys[e] = 0u; --drop; }
            }
            __syncthreads();
        }
        u64* mrow = WSP(u64, WS_MASK) + ((size_t)b * TP + i) * NTILE;
        for (int r = 0; r < 5; ++r) { const int t = wave + 8 * r; const int e = t * 64 + lane;
            const bool sel = (e < n) && (keys[e < n ? e : 0] >= prefix) && prefix != 0u;
            const u64 w = __ballot(sel);
            if (t <= c && lane == 0) mrow[t] = w; }
    }
    __syncthreads();
}

__device__ __forceinline__ float log_sigmoid(float x) { return fminf(x, 0.f) - log1pf(expf(-fabsf(x))); }
__device__ __forceinline__ void gla_naive_unit(Ctx& C, int b, int h) {
    LAS float* qs = (LAS float*)C.lds; LAS float* ks = qs + 4096; LAS float* as = ks + 4096; LAS float* vs = as + 4096; LAS float* os = vs + 8192;
    LAS float* red = os + 8192; LAS float* lrs = red + 1024;
    const int tid = C.tid, dv = tid & 127, kg = tid >> 7;
    float S[16];
#pragma unroll
    for (int r = 0; r < 16; ++r) S[r] = 0.f;
    float wg[16]; const int dg = tid & 63;
#pragma unroll
    for (int r = 0; r < 16; ++r) wg[r] = IN_(5)[r * 256 + h * 64 + dg];
    const float bgv = IN_(6)[h * 64 + dg];
#pragma unroll 1
    for (int c = 0; c < NTILE; ++c) {
        const size_t rb = (size_t)b * TP + c * 64;
        __syncthreads();
        { const int t = tid >> 3, d0 = (tid & 7) * 8; const bf16_t* row = WSP(bf16_t, WS_PROJ) + (rb + t) * PC;
          const u32x4 qv = *(const u32x4*)(row + C_BQ + h * 64 + d0), kv = *(const u32x4*)(row + C_BK + h * 64 + d0);
          LAS float* qd = qs + t * 64 + d0; LAS float* kd = ks + t * 64 + d0;
          qd[0] = bflo(qv.x); qd[1] = bfhi(qv.x); qd[2] = bflo(qv.y); qd[3] = bfhi(qv.y); qd[4] = bflo(qv.z); qd[5] = bfhi(qv.z); qd[6] = bflo(qv.w); qd[7] = bfhi(qv.w);
          kd[0] = bflo(kv.x); kd[1] = bfhi(kv.x); kd[2] = bflo(kv.y); kd[3] = bfhi(kv.y); kd[4] = bflo(kv.z); kd[5] = bfhi(kv.z); kd[6] = bflo(kv.w); kd[7] = bfhi(kv.w);
          const int e0 = (tid & 7) * 16; const u32x4 v0 = *(const u32x4*)(row + C_BV + h * 128 + e0), v1 = *(const u32x4*)(row + C_BV + h * 128 + e0 + 8);
          LAS float* vd = vs + t * 128 + e0;
          vd[0] = bflo(v0.x); vd[1] = bfhi(v0.x); vd[2] = bflo(v0.y); vd[3] = bfhi(v0.y); vd[4] = bflo(v0.z); vd[5] = bfhi(v0.z); vd[6] = bflo(v0.w); vd[7] = bfhi(v0.w);
          vd[8] = bflo(v1.x); vd[9] = bfhi(v1.x); vd[10] = bflo(v1.y); vd[11] = bfhi(v1.y); vd[12] = bflo(v1.z); vd[13] = bfhi(v1.z); vd[14] = bflo(v1.w); vd[15] = bfhi(v1.w);
          if (tid < 128) { const int t2 = tid >> 1, r0 = (tid & 1) * 8; const u32x4 lv = *(const u32x4*)(WSP(bf16_t, WS_PROJ) + (rb + t2) * PC + C_LR + r0); LAS float* ld = lrs + t2 * 16 + r0;
              ld[0] = bflo(lv.x); ld[1] = bfhi(lv.x); ld[2] = bflo(lv.y); ld[3] = bfhi(lv.y); ld[4] = bflo(lv.z); ld[5] = bfhi(lv.z); ld[6] = bflo(lv.w); ld[7] = bfhi(lv.w); } }
        __syncthreads();
        { const int tg = tid >> 6;
#pragma unroll
          for (int j = 0; j < 8; ++j) { const int t = tg * 8 + j; float x = bgv;
#pragma unroll
              for (int r = 0; r < 16; ++r) x += lrs[t * 16 + r] * wg[r];
              as[t * 64 + dg] = expf(log_sigmoid(x) * (1.f / 16.f)); } }
        __syncthreads();
#pragma unroll 1
        for (int t = 0; t < 64; ++t) {
            const float vv = vs[t * 128 + dv]; float part = 0.f;
#pragma unroll
            for (int r = 0; r < 16; ++r) { const int dk = kg * 16 + r; S[r] = as[t * 64 + dk] * S[r] + ks[t * 64 + dk] * vv; part += qs[t * 64 + dk] * S[r]; }
            LAS float* rd = red + (t & 1) * 512;
            rd[kg * 128 + dv] = part;
            __syncthreads();
            if (kg == 0) os[t * 128 + dv] = (rd[dv] + rd[128 + dv]) + (rd[256 + dv] + rd[384 + dv]);
        }
        __syncthreads();
        { const int t = tid >> 3, sub = tid & 7, i = c * 64 + t; float o[16]; float ss = 0.f;
#pragma unroll
          for (int j = 0; j < 16; ++j) { o[j] = os[t * 128 + sub * 16 + j]; ss += o[j] * o[j]; }
          ss += __shfl_xor(ss, 1); ss += __shfl_xor(ss, 2); ss += __shfl_xor(ss, 4);
          const float rstd = 1.f / sqrtf(ss * (1.f / 128.f) + 1e-6f);
          if (i >= 48) {
              const bf16_t* ogp = WSP(bf16_t, WS_PROJ) + (rb + t) * PC + C_OG + h * 128 + sub * 16;
              bf16_t* dst = (i >= 64) ? WSP(bf16_t, WS_MIXED) + ((size_t)b * SEQ + (i - 64)) * DM + 512 + h * 128 + sub * 16 : WSP(bf16_t, WS_MIXM) + ((size_t)b * 16 + (i - 48)) * DM + 512 + h * 128 + sub * 16;
              float w[16];
#pragma unroll
              for (int j = 0; j < 16; ++j) { const float g = bf2f(ogp[j]); const float sl = g / (1.f + expf(-g)); w[j] = o[j] * rstd * IN_(8)[h * 128 + sub * 16 + j] * sl; }
              float w0[8], w1[8];
#pragma unroll
              for (int j = 0; j < 8; ++j) { w0[j] = w[j]; w1[j] = w[8 + j]; }
              store8_bf16(dst, w0); store8_bf16(dst + 8, w1);
          } }
    }
    __syncthreads();
}

__device__ __forceinline__ void phase_attn_naive(Ctx& C) {
    LAS float* lg = (LAS float*)C.lds;
    LAS float* qs = lg + 8 * TP;
    const int tid = C.tid, lane = C.lane, h = C.wave;
    const float slope2 = exp2f(-(float)(h + 1)) * LOG2E;
    const int NQ = BATCH * (TP - 48);
    for (int q = C.bid; q < NQ; q += C.G) {
        const int b = q / (TP - 48), i = 48 + q % (TP - 48), c = i >> 6;
        const bf16_t* qrow = WSP(bf16_t, WS_PROJ) + ((size_t)b * TP + i) * PC;
        __syncthreads();
        qs[tid] = bf2f(qrow[C_AQ + tid]);
        __syncthreads();
        const u64* mrow = WSP(u64, WS_MASK) + ((size_t)b * TP + i) * NTILE;
        float mx = -INFINITY;
        for (int t = 0; t <= c; ++t) {
            const u64 w = mrow[t]; const int j = t * 64 + lane; float l = -INFINITY;
            if ((w >> lane) & 1ull) {
                const u32x4* kp = (const u32x4*)(WSP(bf16_t, WS_PROJ) + ((size_t)b * TP + j) * PC + C_AK + h * 64); float d = 0.f;
#pragma unroll
                for (int jj = 0; jj < 8; ++jj) { const u32x4 kk = kp[jj]; const LAS float* qq = qs + h * 64 + jj * 8;
                    d += qq[0] * bflo(kk.x) + qq[1] * bfhi(kk.x) + qq[2] * bflo(kk.y) + qq[3] * bfhi(kk.y) + qq[4] * bflo(kk.z) + qq[5] * bfhi(kk.z) + qq[6] * bflo(kk.w) + qq[7] * bfhi(kk.w); }
                const int dist = i > j ? i - j : j - i;
                l = d - slope2 * (float)dist;
            }
            lg[h * TP + j] = l; mx = fmaxf(mx, l);
        }
        mx = wave_max(mx);
        float sum = 0.f;
        for (int t = 0; t <= c; ++t) { const int j = t * 64 + lane; const float l = lg[h * TP + j]; const float p = (l == -INFINITY) ? 0.f : exp2f(l - mx); lg[h * TP + j] = p; sum += p; }
        sum = wave_sum(sum);
        LDS_WAIT();
        float acc = 0.f;
        for (int t = 0; t <= c; ++t) {
            const u64 w = mrow[t];
            unsigned lo = __builtin_amdgcn_readfirstlane((unsigned)w), hi = __builtin_amdgcn_readfirstlane((unsigned)(w >> 32));
            const bf16_t* vb = WSP(bf16_t, WS_PROJ) + ((size_t)b * TP + t * 64) * PC + C_AV + h * 64 + lane;
            while (lo) { const int k = __builtin_ctz(lo); lo &= lo - 1u; acc += lg[h * TP + t * 64 + k] * bf2f(vb[(size_t)k * PC]); }
            while (hi) { const int k = 32 + __builtin_ctz(hi); hi &= hi - 1u; acc += lg[h * TP + t * 64 + k] * bf2f(vb[(size_t)k * PC]); }
        }
        const float o = acc / sum;
        const float ms = wave_sum(o * o) * (1.f / 64.f);
        const float val = o * (1.f / sqrtf(ms + 1e-6f)) * IN_(7)[h * 64 + lane];
        bf16_t* dst = (i >= 64) ? WSP(bf16_t, WS_MIXED) + ((size_t)b * SEQ + (i - 64)) * DM + h * 64 + lane : WSP(bf16_t, WS_MIXM) + ((size_t)b * 16 + (i - 48)) * DM + h * 64 + lane;
        *dst = (bf16_t)f2bf(val);
    }
    __syncthreads();
}


namespace gla {
typedef short bf16x8 __attribute__((ext_vector_type(8)));
typedef short bf16x4 __attribute__((ext_vector_type(4)));
typedef float f32x16 __attribute__((ext_vector_type(16)));
constexpr int RP = 144;
constexpr int L_QT = 0, L_KT = L_QT + 64 * RP, L_KH = L_KT + 64 * RP, L_VT = L_KH + 64 * RP, L_ST = L_VT + 128 * RP, L_GT = L_ST + 128 * RP;
constexpr int L_DL = L_GT + 8 * 64 * 4, L_WG = L_DL + 256, L_OS = L_WG + 16 * 64 * 4, OSP = 132, L_END = L_OS + 64 * OSP * 4;
static_assert(L_END <= 131072, "gla LDS");
__device__ __forceinline__ int crow(int r, int hi) { return (r & 3) + 8 * (r >> 2) + 4 * hi; }
__device__ __forceinline__ unsigned cvtpk(float lo, float hi) { typedef float f2 __attribute__((ext_vector_type(2))); typedef __bf16 b2 __attribute__((ext_vector_type(2))); f2 v = {lo, hi}; b2 b = __builtin_convertvector(v, b2); return __builtin_bit_cast(unsigned, b); }
__device__ __forceinline__ float logsig(float x) { return fminf(x, 0.f) - __logf(1.f + __expf(-fabsf(x))); }

__device__ __forceinline__ void gla_unit(Ctx& C, int b, int h) {
    const int tid = C.tid, lane = C.lane, wid = C.wave, r32 = lane & 31, hi = lane >> 5;
    const int t = tid >> 3, d8 = (tid & 7) * 8, dv16 = (tid & 7) * 16;
    const int tb = wid >> 2, db = wid & 3;
    LAS unsigned char* L = C.lds;
    LAS float* GT = (LAS float*)(L + L_GT); LAS float* DL = (LAS float*)(L + L_DL); LAS float* WG = (LAS float*)(L + L_WG); LAS float* OS = (LAS float*)(L + L_OS);
    const bf16_t* P = WSP(bf16_t, WS_PROJ) + (size_t)b * TP * PC;
    __syncthreads();
    for (int e = tid; e < 16 * 64; e += NTHR) WG[e] = IN_(5)[(e >> 6) * 256 + h * 64 + (e & 63)];
    for (int e = tid; e < 128 * RP / 4; e += NTHR) ((LAS unsigned*)(L + L_ST))[e] = 0u;
    float bg8[8];
#pragma unroll
    for (int j = 0; j < 8; ++j) bg8[j] = IN_(6)[h * 64 + d8 + j];
    float gn16[16];
#pragma unroll
    for (int j = 0; j < 16; ++j) gn16[j] = IN_(8)[h * 128 + dv16 + j];
    f32x16 Sacc = f32x16{};
    const bf16_t* row0 = P + (size_t)t * PC;
    u32x4 nq = *(const u32x4*)(row0 + C_BQ + h * 64 + d8), nk = *(const u32x4*)(row0 + C_BK + h * 64 + d8);
    u32x4 nl0 = *(const u32x4*)(row0 + C_LR), nl1 = *(const u32x4*)(row0 + C_LR + 8);
    u32x4 nv0 = *(const u32x4*)(row0 + C_BV + h * 128 + dv16), nv1 = *(const u32x4*)(row0 + C_BV + h * 128 + dv16 + 8);
    u32x4 ng0 = *(const u32x4*)(row0 + C_OG + h * 128 + dv16), ng1 = *(const u32x4*)(row0 + C_OG + h * 128 + dv16 + 8);
    __syncthreads();
#pragma unroll 1
    for (int c = 0; c < NTILE; ++c) {
        const u32x4 cq = nq, ck = nk, cl0 = nl0, cl1 = nl1, cv0 = nv0, cv1 = nv1, cg0 = ng0, cg1 = ng1;
        if (c + 1 < NTILE) { const bf16_t* row = P + (size_t)((c + 1) * 64 + t) * PC;
            nq = *(const u32x4*)(row + C_BQ + h * 64 + d8); nk = *(const u32x4*)(row + C_BK + h * 64 + d8);
            nl0 = *(const u32x4*)(row + C_LR); nl1 = *(const u32x4*)(row + C_LR + 8);
            nv0 = *(const u32x4*)(row + C_BV + h * 128 + dv16); nv1 = *(const u32x4*)(row + C_BV + h * 128 + dv16 + 8);
            ng0 = *(const u32x4*)(row + C_OG + h * 128 + dv16); ng1 = *(const u32x4*)(row + C_OG + h * 128 + dv16 + 8); }
        float g[8];
        { const float lf[16] = {bflo(cl0.x), bfhi(cl0.x), bflo(cl0.y), bfhi(cl0.y), bflo(cl0.z), bfhi(cl0.z), bflo(cl0.w), bfhi(cl0.w), bflo(cl1.x), bfhi(cl1.x), bflo(cl1.y), bfhi(cl1.y), bflo(cl1.z), bfhi(cl1.z), bflo(cl1.w), bfhi(cl1.w)};
#pragma unroll
          for (int j = 0; j < 8; ++j) g[j] = bg8[j];
#pragma unroll
          for (int r = 0; r < 16; ++r) { const f32x4 w0 = *(const LAS f32x4*)(WG + r * 64 + d8), w1 = *(const LAS f32x4*)(WG + r * 64 + d8 + 4);
              g[0] += lf[r] * w0[0]; g[1] += lf[r] * w0[1]; g[2] += lf[r] * w0[2]; g[3] += lf[r] * w0[3]; g[4] += lf[r] * w1[0]; g[5] += lf[r] * w1[1]; g[6] += lf[r] * w1[2]; g[7] += lf[r] * w1[3]; }
#pragma unroll
          for (int j = 0; j < 8; ++j) g[j] = logsig(g[j]) * (1.f / 16.f); }
#pragma unroll
        for (int off = 8; off < 64; off <<= 1) {
#pragma unroll
            for (int j = 0; j < 8; ++j) { const float tv = __shfl_up(g[j], off); if (lane >= off) g[j] += tv; } }
        if (lane >= 56) {
#pragma unroll
            for (int j = 0; j < 8; ++j) GT[wid * 64 + d8 + j] = g[j]; }
        __syncthreads();
        { float offs[8], bl[8];
#pragma unroll
          for (int j = 0; j < 8; ++j) { offs[j] = 0.f; bl[j] = 0.f; }
#pragma unroll
          for (int w2 = 0; w2 < 8; ++w2) { const f32x4 a0 = *(const LAS f32x4*)(GT + w2 * 64 + d8), a1 = *(const LAS f32x4*)(GT + w2 * 64 + d8 + 4);
              const float av[8] = {a0[0], a0[1], a0[2], a0[3], a1[0], a1[1], a1[2], a1[3]};
#pragma unroll
              for (int j = 0; j < 8; ++j) { bl[j] += av[j]; if (w2 < wid) offs[j] += av[j]; } }
          const float qv[8] = {bflo(cq.x), bfhi(cq.x), bflo(cq.y), bfhi(cq.y), bflo(cq.z), bfhi(cq.z), bflo(cq.w), bfhi(cq.w)};
          const float kv[8] = {bflo(ck.x), bfhi(ck.x), bflo(ck.y), bfhi(ck.y), bflo(ck.z), bfhi(ck.z), bflo(ck.w), bfhi(ck.w)};
          float qt_[8], kt_[8], kh_[8];
#pragma unroll
          for (int j = 0; j < 8; ++j) { const float bb = g[j] + offs[j]; const float eb = __expf(bb); qt_[j] = qv[j] * eb; kt_[j] = kv[j] * __expf(-bb); kh_[j] = kv[j] * __expf(bl[j] - bb); }
          *(LAS u32x4*)(L + L_QT + t * RP + d8 * 2) = (u32x4){cvtpk(qt_[0], qt_[1]), cvtpk(qt_[2], qt_[3]), cvtpk(qt_[4], qt_[5]), cvtpk(qt_[6], qt_[7])};
          *(LAS u32x4*)(L + L_KT + t * RP + d8 * 2) = (u32x4){cvtpk(kt_[0], kt_[1]), cvtpk(kt_[2], kt_[3]), cvtpk(kt_[4], kt_[5]), cvtpk(kt_[6], kt_[7])};
#pragma unroll
          for (int j = 0; j < 8; ++j) *(LAS unsigned short*)(L + L_KH + (d8 + j) * RP + t * 2) = (unsigned short)f2bf(kh_[j]);
          if (t == 0) {
#pragma unroll
              for (int j = 0; j < 8; ++j) DL[d8 + j] = __expf(bl[j]); }
          const unsigned vw[8] = {cv0.x, cv0.y, cv0.z, cv0.w, cv1.x, cv1.y, cv1.z, cv1.w};
#pragma unroll
          for (int j = 0; j < 8; ++j) { *(LAS unsigned short*)(L + L_VT + (dv16 + 2 * j) * RP + t * 2) = (unsigned short)(vw[j] & 0xffffu);
                                         *(LAS unsigned short*)(L + L_VT + (dv16 + 2 * j + 1) * RP + t * 2) = (unsigned short)(vw[j] >> 16); } }
        __syncthreads();
        f32x16 o = f32x16{};
        { bf16x8 qf[4];
#pragma unroll
          for (int ks = 0; ks < 4; ++ks) qf[ks] = *(const LAS bf16x8*)(L + L_QT + (32 * tb + r32) * RP + (16 * ks + 8 * hi) * 2);
#pragma unroll
          for (int ks = 0; ks < 4; ++ks) { const bf16x8 sf = *(const LAS bf16x8*)(L + L_ST + (32 * db + r32) * RP + (16 * ks + 8 * hi) * 2); o = __builtin_amdgcn_mfma_f32_32x32x16_bf16(qf[ks], sf, o, 0, 0, 0); }
          for (int jb = 0; jb <= tb; ++jb) {
              f32x16 p = f32x16{};
#pragma unroll
              for (int ks = 0; ks < 4; ++ks) { const bf16x8 kf = *(const LAS bf16x8*)(L + L_KT + (32 * jb + r32) * RP + (16 * ks + 8 * hi) * 2); p = __builtin_amdgcn_mfma_f32_32x32x16_bf16(kf, qf[ks], p, 0, 0, 0); }
              if (jb == tb) {
#pragma unroll
                  for (int r = 0; r < 16; ++r) if (crow(r, hi) > r32) p[r] = 0.f; }
              const u32x4 pw0 = (u32x4){cvtpk(p[0], p[1]), cvtpk(p[2], p[3]), cvtpk(p[4], p[5]), cvtpk(p[6], p[7])};
              const u32x4 pw1 = (u32x4){cvtpk(p[8], p[9]), cvtpk(p[10], p[11]), cvtpk(p[12], p[13]), cvtpk(p[14], p[15])};
              const LAS unsigned char* vrow = L + L_VT + (32 * db + r32) * RP + (32 * jb + 4 * hi) * 2;
              const bf16x4 a0 = *(const LAS bf16x4*)(vrow), a1 = *(const LAS bf16x4*)(vrow + 16), a2 = *(const LAS bf16x4*)(vrow + 32), a3 = *(const LAS bf16x4*)(vrow + 48);
              const bf16x8 v0 = (bf16x8){a0[0], a0[1], a0[2], a0[3], a1[0], a1[1], a1[2], a1[3]}, v1 = (bf16x8){a2[0], a2[1], a2[2], a2[3], a3[0], a3[1], a3[2], a3[3]};
              o = __builtin_amdgcn_mfma_f32_32x32x16_bf16(__builtin_bit_cast(bf16x8, pw0), v0, o, 0, 0, 0);
              o = __builtin_amdgcn_mfma_f32_32x32x16_bf16(__builtin_bit_cast(bf16x8, pw1), v1, o, 0, 0, 0);
          }
#pragma unroll
          for (int r = 0; r < 16; ++r) Sacc[r] *= DL[32 * tb + crow(r, hi)];
#pragma unroll
          for (int ks = 0; ks < 4; ++ks) { const bf16x8 af = *(const LAS bf16x8*)(L + L_KH + (32 * tb + r32) * RP + (16 * ks + 8 * hi) * 2);
              const bf16x8 bf = *(const LAS bf16x8*)(L + L_VT + (32 * db + r32) * RP + (16 * ks + 8 * hi) * 2); Sacc = __builtin_amdgcn_mfma_f32_32x32x16_bf16(af, bf, Sacc, 0, 0, 0); } }
        __syncthreads();
#pragma unroll
        for (int rg = 0; rg < 4; ++rg) { typedef unsigned u32x2 __attribute__((ext_vector_type(2)));
            *(LAS u32x2*)(L + L_ST + (32 * db + r32) * RP + (32 * tb + 8 * rg + 4 * hi) * 2) = (u32x2){cvtpk(Sacc[4 * rg], Sacc[4 * rg + 1]), cvtpk(Sacc[4 * rg + 2], Sacc[4 * rg + 3])}; }
#pragma unroll
        for (int r = 0; r < 16; ++r) OS[(32 * tb + crow(r, hi)) * OSP + 32 * db + r32] = o[r];
        __syncthreads();
        { const int i = c * 64 + t; float ov[16]; float ss = 0.f;
#pragma unroll
          for (int j4 = 0; j4 < 4; ++j4) { const f32x4 x4 = *(const LAS f32x4*)(OS + t * OSP + dv16 + 4 * j4); ov[4 * j4] = x4[0]; ov[4 * j4 + 1] = x4[1]; ov[4 * j4 + 2] = x4[2]; ov[4 * j4 + 3] = x4[3];
              ss += (x4[0] * x4[0] + x4[1] * x4[1]) + (x4[2] * x4[2] + x4[3] * x4[3]); }
          ss += __shfl_xor(ss, 1); ss += __shfl_xor(ss, 2); ss += __shfl_xor(ss, 4);
          const float rstd = 1.f / sqrtf(ss * (1.f / 128.f) + 1e-6f);
          if (i >= 48) {
              const unsigned gw[8] = {cg0.x, cg0.y, cg0.z, cg0.w, cg1.x, cg1.y, cg1.z, cg1.w};
              float w[16];
#pragma unroll
              for (int j = 0; j < 8; ++j) { const float ga = bflo(gw[j]), gb = bfhi(gw[j]);
                  w[2 * j] = ov[2 * j] * rstd * gn16[2 * j] * (ga / (1.f + __expf(-ga))); w[2 * j + 1] = ov[2 * j + 1] * rstd * gn16[2 * j + 1] * (gb / (1.f + __expf(-gb))); }
              bf16_t* dst = (i >= 64) ? WSP(bf16_t, WS_MIXED) + ((size_t)b * SEQ + (i - 64)) * DM + 512 + h * 128 + dv16 : WSP(bf16_t, WS_MIXM) + ((size_t)b * 16 + (i - 48)) * DM + 512 + h * 128 + dv16;
              float w0[8], w1[8];
#pragma unroll
              for (int j = 0; j < 8; ++j) { w0[j] = w[j]; w1[j] = w[8 + j]; }
              store8_bf16(dst, w0); store8_bf16(dst + 8, w1);
          } }
    }
    __syncthreads();
}
}
#ifndef FAST_GLA
#define FAST_GLA 1
#endif
#ifndef GLA_SEP
#define GLA_SEP 0
#endif
#ifndef SELB_N
#define SELB_N 2
#endif
#ifndef SELA_REP
#define SELA_REP 1
#endif
#ifndef SELB_REP
#define SELB_REP 1
#endif
namespace sel {
typedef short bf16x8 __attribute__((ext_vector_type(8)));
constexpr int SCP = 2116;
constexpr int CW_QSEL = 64;
__device__ __forceinline__ unsigned unsortable(unsigned u) { return (u & 0x80000000u) ? (u & 0x7fffffffu) : ~u; }
__device__ __forceinline__ unsigned wave_min_u(unsigned v) {
#pragma unroll
    for (int o = 1; o < 64; o <<= 1) { const unsigned t = (unsigned)__shfl_xor((int)v, o); v = t < v ? t : v; }
    return v; }
__device__ __forceinline__ unsigned wave_max_u(unsigned v) {
#pragma unroll
    for (int o = 1; o < 64; o <<= 1) { const unsigned t = (unsigned)__shfl_xor((int)v, o); v = t > v ? t : v; }
    return v; }

#define DPP_RED(v, OP) do { v = OP(v, (unsigned)__builtin_amdgcn_update_dpp((int)v, (int)v, 0xB1, 0xf, 0xf, false)); v = OP(v, (unsigned)__builtin_amdgcn_update_dpp((int)v, (int)v, 0x4E, 0xf, 0xf, false)); \
    v = OP(v, (unsigned)__builtin_amdgcn_update_dpp((int)v, (int)v, 0x141, 0xf, 0xf, false)); v = OP(v, (unsigned)__builtin_amdgcn_update_dpp((int)v, (int)v, 0x140, 0xf, 0xf, false)); } while (0)
__device__ __forceinline__ unsigned uadd(unsigned a, unsigned b) { return a + b; }
__device__ __forceinline__ unsigned umin_(unsigned a, unsigned b) { return a < b ? a : b; }
__device__ __forceinline__ unsigned umax_(unsigned a, unsigned b) { return a > b ? a : b; }
__device__ __forceinline__ unsigned wave_add_dpp(unsigned v) { DPP_RED(v, uadd); return (unsigned)__builtin_amdgcn_readlane((int)v, 0) + (unsigned)__builtin_amdgcn_readlane((int)v, 16) + (unsigned)__builtin_amdgcn_readlane((int)v, 32) + (unsigned)__builtin_amdgcn_readlane((int)v, 48); }
__device__ __forceinline__ unsigned wave_min_dpp(unsigned v) { DPP_RED(v, umin_); return umin_(umin_((unsigned)__builtin_amdgcn_readlane((int)v, 0), (unsigned)__builtin_amdgcn_readlane((int)v, 16)), umin_((unsigned)__builtin_amdgcn_readlane((int)v, 32), (unsigned)__builtin_amdgcn_readlane((int)v, 48))); }
__device__ __forceinline__ unsigned wave_max_dpp(unsigned v) { DPP_RED(v, umax_); return umax_(umax_((unsigned)__builtin_amdgcn_readlane((int)v, 0), (unsigned)__builtin_amdgcn_readlane((int)v, 16)), umax_((unsigned)__builtin_amdgcn_readlane((int)v, 32), (unsigned)__builtin_amdgcn_readlane((int)v, 48))); }
#ifndef BIS_REP
#define BIS_REP 1
#endif
#ifndef ITER_PROBE
#define ITER_PROBE 0
#endif
#ifndef SEL_VALU_COUNT
#define SEL_VALU_COUNT 1
#endif
template <int NS> __device__ __forceinline__ void select_query(Ctx& C, LAS float* scq, int c, u64* mrow) {
    const int lane = C.lane;
    unsigned k[NS];
    unsigned kmin = 0xFFFFFFFFu, kmax = 0u;
#pragma unroll
    for (int s = 0; s < NS; ++s) {
        if (s <= c) { k[s] = sortable(scq[64 * s + lane]); kmax = k[s] > kmax ? k[s] : kmax; if (s >= 1) kmin = k[s] < kmin ? k[s] : kmin; }
        else k[s] = 0u;
    }
    kmin = wave_min_dpp(kmin); kmax = wave_max_dpp(kmax);
    unsigned lo = kmin, hi = kmax + 1u, cnt_hi = 0u, thr = 0u;
    bool exact = false; int it_done = 0;
#pragma unroll 1
    for (int brep = 0; brep < BIS_REP; ++brep) { lo = kmin; hi = kmax + 1u; cnt_hi = 0u; exact = false;
    for (int it = 0; it < 48; ++it) {
        if (hi - lo <= 1u) break;
        it_done = it + 1;
        unsigned mid = lo + ((hi - lo) >> 1);
        if (it < 12) { const float fm = 0.5f * __uint_as_float(unsortable(lo)) + 0.5f * __uint_as_float(unsortable(hi)); const unsigned mk = sortable(fm); if (mk > lo && mk < hi) mid = mk; }
        unsigned cnt = 0u;
#if SEL_VALU_COUNT
        { unsigned c0 = 0u, c1 = 0u, c2 = 0u, c3 = 0u;
#pragma unroll
          for (int s = 0; s < NS; ++s) { const unsigned inc = (k[s] >= mid) ? 1u : 0u; if ((s & 3) == 0) c0 += inc; else if ((s & 3) == 1) c1 += inc; else if ((s & 3) == 2) c2 += inc; else c3 += inc; }
          cnt = wave_add_dpp((c0 + c1) + (c2 + c3)); }
#else
#pragma unroll
        for (int s = 0; s < NS; ++s) { cnt += (unsigned)__popcll(__ballot(k[s] >= mid)); if ((s & 7) == 7) __builtin_amdgcn_sched_barrier(0); }
#endif
        if (cnt == (unsigned)TOPK) { exact = true; thr = mid; break; }
        if (cnt > (unsigned)TOPK) lo = mid; else { hi = mid; cnt_hi = cnt; }
    }
    asm volatile("" : "+s"(lo), "+s"(hi));
    }
#if ITER_PROBE
    if (lane == 0) atomicAdd((unsigned*)C.a->ws + 96, (unsigned)it_done);
#endif
    unsigned need = 0u;
    if (!exact) { thr = lo; need = (unsigned)TOPK - cnt_hi; }
    u64 myw = 0ull;
#pragma unroll
    for (int s = 0; s < NS; ++s) {
        u64 w;
        if (exact) w = __ballot(k[s] >= thr);
        else {
            w = __ballot(k[s] > thr);
            u64 eq = __ballot(k[s] == thr);
            const unsigned ce = (unsigned)__popcll(eq);
            if (ce <= need) { w |= eq; need -= ce; }
            else { while (need) { const u64 bit = eq & (0ull - eq); w |= bit; eq ^= bit; --need; } }
        }
        if (lane == s) myw = w;
        __builtin_amdgcn_sched_barrier(0);
    }
    if (lane <= c) mrow[lane] = myw;
}

#ifndef SEL_NOCMP
#define SEL_NOCMP 0
#endif
__device__ __forceinline__ float wave_fmin_dpp(float v) { unsigned u = sortable(v); u = wave_min_dpp(u); return __uint_as_float(unsortable(u)); }
__device__ __forceinline__ float wave_fmax_dpp(float v) { unsigned u = sortable(v); u = wave_max_dpp(u); return __uint_as_float(unsortable(u)); }
template <int NS> __device__ __forceinline__ void select_query2(Ctx& C, LAS float* scA, LAS float* scB, int c, u64* mrowA, u64* mrowB) {
    const int lane = C.lane;
    float fA[NS], fB[NS];
    float mnA = INFINITY, mxA = -INFINITY, mnB = INFINITY, mxB = -INFINITY;
#pragma unroll
    for (int s = 0; s < NS; ++s) {
        if (s <= c) { fA[s] = scA[64 * s + lane]; fB[s] = scB[64 * s + lane]; mxA = fmaxf(mxA, fA[s]); mxB = fmaxf(mxB, fB[s]); if (s >= 1) { mnA = fminf(mnA, fA[s]); mnB = fminf(mnB, fB[s]); } }
        else { fA[s] = -INFINITY; fB[s] = -INFINITY; }
    }
    unsigned loA = sortable(wave_fmin_dpp(mnA)), hiA = sortable(wave_fmax_dpp(mxA)) + 1u, loB = sortable(wave_fmin_dpp(mnB)), hiB = sortable(wave_fmax_dpp(mxB)) + 1u;
    unsigned chA = 0u, chB = 0u, thrA = 0u, thrB = 0u; bool exA = false, exB = false, dnA = false, dnB = false;
    float clA = (float)(64 * c + 16), clB = clA; int sdA = 0, sdB = 0, itp = 0;
    for (int it = 0; it < 48; ++it) {
        if (!dnA && hiA - loA <= 1u) dnA = true;
        if (!dnB && hiB - loB <= 1u) dnB = true;
        if (dnA && dnB) break;
        itp = it + 1;
        unsigned midA = loA + ((hiA - loA) >> 1), midB = loB + ((hiB - loB) >> 1);
        if (it < 16) {
            const float la = __uint_as_float(unsortable(loA)), ha = __uint_as_float(unsortable(hiA)), lb = __uint_as_float(unsortable(loB)), hb = __uint_as_float(unsortable(hiB));
            float fra = 0.5f, frb = 0.5f;
            if (it >= 2 && sdA < 2 && sdA > -2) { fra = (clA - 256.f) / (clA - (float)chA); fra = fminf(fmaxf(fra, 0.06f), 0.94f); }
            if (it >= 2 && sdB < 2 && sdB > -2) { frb = (clB - 256.f) / (clB - (float)chB); frb = fminf(fmaxf(frb, 0.06f), 0.94f); }
            const unsigned ma = sortable(la + fra * (ha - la)), mb = sortable(lb + frb * (hb - lb));
            if (ma > loA && ma < hiA) midA = ma;
            if (mb > loB && mb < hiB) midB = mb; }
        const float tA = __uint_as_float(unsortable(midA)), tB = __uint_as_float(unsortable(midB));
        unsigned a0 = 0u, a1 = 0u, b0 = 0u, b1 = 0u;
#pragma unroll
        for (int s = 0; s < NS; ++s) { const unsigned ia = __float_as_uint(fA[s] - tA) >> 31, ib = __float_as_uint(fB[s] - tB) >> 31; if (s & 1) { a1 += ia; b1 += ib; } else { a0 += ia; b0 += ib; } }
        unsigned pk = (a0 + a1) | ((b0 + b1) << 16);
        pk = wave_add_dpp(pk);
        const unsigned cntA = (unsigned)(NS * 64) - (pk & 0xffffu), cntB = (unsigned)(NS * 64) - (pk >> 16);
        if (!dnA) { if (cntA == (unsigned)TOPK) { exA = true; thrA = midA; dnA = true; } else if (cntA > (unsigned)TOPK) { loA = midA; clA = (float)cntA; sdA = sdA > 0 ? sdA + 1 : 1; } else { hiA = midA; chA = cntA; sdA = sdA < 0 ? sdA - 1 : -1; } }
        if (!dnB) { if (cntB == (unsigned)TOPK) { exB = true; thrB = midB; dnB = true; } else if (cntB > (unsigned)TOPK) { loB = midB; clB = (float)cntB; sdB = sdB > 0 ? sdB + 1 : 1; } else { hiB = midB; chB = cntB; sdB = sdB < 0 ? sdB - 1 : -1; } }
    }
#if ITER_PROBE
    if (lane == 0) atomicAdd((unsigned*)C.a->ws + 96, (unsigned)itp);
#endif
    unsigned needA = 0u, needB = 0u;
    if (!exA) { thrA = loA; needA = (unsigned)TOPK - chA; }
    if (!exB) { thrB = loB; needB = (unsigned)TOPK - chB; }
    const float tfA = __uint_as_float(unsortable(thrA)), tfB = __uint_as_float(unsortable(thrB));
    u64 mywA = 0ull, mywB = 0ull;
#pragma unroll
    for (int s = 0; s < NS; ++s) {
        u64 wA, wB;
        if (exA) wA = __ballot(fA[s] >= tfA);
        else { wA = __ballot(fA[s] > tfA); u64 eq = __ballot(fA[s] == tfA); const unsigned ce = (unsigned)__popcll(eq);
            if (ce <= needA) { wA |= eq; needA -= ce; } else { while (needA) { const u64 bit = eq & (0ull - eq); wA |= bit; eq ^= bit; --needA; } } }
        if (exB) wB = __ballot(fB[s] >= tfB);
        else { wB = __ballot(fB[s] > tfB); u64 eq = __ballot(fB[s] == tfB); const unsigned ce = (unsigned)__popcll(eq);
            if (ce <= needB) { wB |= eq; needB -= ce; } else { while (needB) { const u64 bit = eq & (0ull - eq); wB |= bit; eq ^= bit; --needB; } } }
        if (lane == s) { mywA = wA; mywB = wB; }
        __builtin_amdgcn_sched_barrier(0);
    }
    if (lane <= c) { mrowA[lane] = mywA; mrowB[lane] = mywB; }
}
#ifndef SEL_PAIR
#define SEL_PAIR 1
#endif
template <bool SCORE_F32> __device__ __forceinline__ void select_unit(Ctx& C, int b, int c, int g) {
    const int lane = C.lane, wid = C.wave, tid = C.tid;
    LAS float* sc = (LAS float*)C.lds;
    const int i0 = 64 * c + 16 * g, nkb = 4 * (c + 1);
    const bf16_t* P = WSP(bf16_t, WS_PROJ) + (size_t)b * TP * PC;
#pragma unroll 1
    for (int repA = 0; repA < SELA_REP; ++repA) {
    __syncthreads();
    if (SCORE_F32) {
        const float* X = WSP(float, WS_IDX) + (size_t)b * TP * 384;
        const int q = tid & 15; const float* qf = X + (size_t)(i0 + q) * 384;
        for (int e = tid >> 4; e < 64 * (c + 1); e += 32) { const float* kf = X + (size_t)e * 384 + 256; float tot = 0.f;
            for (int h = 0; h < 4; ++h) { float d = 0.f; for (int j = 0; j < 64; ++j) d += qf[h * 64 + j] * kf[j]; tot += qf[320 + h] * fmaxf(d, 0.f); }
            tot = tot + 0.f; if (e < 48) tot = -INFINITY; sc[q * SCP + e] = tot; }
    } else {
        const int query = lane & 15, kq = lane >> 4;
        const bf16_t* qrow = P + (size_t)(i0 + query) * PC;
        bf16x8 qf[4][2]; float w[4];
#pragma unroll
        for (int h = 0; h < 4; ++h) { qf[h][0] = *(const bf16x8*)(qrow + C_IQ + h * 64 + 8 * kq); qf[h][1] = *(const bf16x8*)(qrow + C_IQ + h * 64 + 32 + 8 * kq); w[h] = bf2f(qrow[C_IW + h]); }
        const bf16_t* kbase = P + (size_t)(lane & 15) * PC + C_IK + 8 * kq;
        bf16x8 ka[4][2], kn[4][2];
#define SEL_LOAD(dst, g) do { _Pragma("unroll") for (int u_ = 0; u_ < 4; ++u_) { const int kb_ = wid + 8 * (4 * (g) + u_); if (kb_ < nkb) { const bf16_t* kr_ = kbase + (size_t)(16 * kb_) * PC; dst[u_][0] = *(const bf16x8*)kr_; dst[u_][1] = *(const bf16x8*)(kr_ + 32); } } } while (0)
#define SEL_COMP(src, g) do { _Pragma("unroll") for (int u_ = 0; u_ < 4; ++u_) { const int kb_ = wid + 8 * (4 * (g) + u_); if (kb_ < nkb) { \
            f32x4 tot = (f32x4){0.f, 0.f, 0.f, 0.f}; \
            _Pragma("unroll") for (int h = 0; h < 4; ++h) { f32x4 acc = (f32x4){0.f, 0.f, 0.f, 0.f}; \
                acc = __builtin_amdgcn_mfma_f32_16x16x32_bf16(src[u_][0], qf[h][0], acc, 0, 0, 0); acc = __builtin_amdgcn_mfma_f32_16x16x32_bf16(src[u_][1], qf[h][1], acc, 0, 0, 0); \
                tot[0] += w[h] * fmaxf(acc[0], 0.f); tot[1] += w[h] * fmaxf(acc[1], 0.f); tot[2] += w[h] * fmaxf(acc[2], 0.f); tot[3] += w[h] * fmaxf(acc[3], 0.f); } \
            tot = tot + 0.f; \
            if (kb_ < 3) tot = (f32x4){-INFINITY, -INFINITY, -INFINITY, -INFINITY}; \
            *(LAS f32x4*)(sc + query * SCP + 16 * kb_ + 4 * kq) = tot; } } } while (0)
        const int ng = (nkb - wid + 31) >> 5;
        SEL_LOAD(ka, 0);
#pragma unroll 1
        for (int g = 0; g < ng; g += 2) {
            if (g + 1 < ng) SEL_LOAD(kn, g + 1);
            SEL_COMP(ka, g);
            if (g + 2 < ng) SEL_LOAD(ka, g + 2);
            if (g + 1 < ng) SEL_COMP(kn, g + 1);
        }
#undef SEL_LOAD
#undef SEL_COMP
    }
    }
    __syncthreads();
#if SEL_PAIR
    { const int qA = 2 * wid, qB = 2 * wid + 1; LAS float* scA = sc + qA * SCP; LAS float* scB = sc + qB * SCP;
      u64* mA = WSP(u64, WS_MASK) + ((size_t)b * TP + i0 + qA) * NTILE; u64* mB = mA + NTILE;
      if (c < 12) select_query2<12>(C, scA, scB, c, mA, mB); else if (c < 20) select_query2<20>(C, scA, scB, c, mA, mB); else if (c < 28) select_query2<28>(C, scA, scB, c, mA, mB); else select_query2<33>(C, scA, scB, c, mA, mB); }
#else
#pragma unroll 1
    for (int qq = 0; qq < SELB_N * SELB_REP; ++qq) {
        const int q = 2 * wid + (qq & 1); LAS float* scq = sc + q * SCP; u64* mrow = WSP(u64, WS_MASK) + ((size_t)b * TP + i0 + q) * NTILE;
        if (c < 12) select_query<12>(C, scq, c, mrow); else if (c < 20) select_query<20>(C, scq, c, mrow); else if (c < 28) select_query<28>(C, scq, c, mrow); else select_query<33>(C, scq, c, mrow);
    }
#endif
    __syncthreads();
}
template <bool SCORE_F32> __device__ __forceinline__ void phase_select_fast(Ctx& C, volatile LAS unsigned* MISC) {
    unsigned* qhead = (unsigned*)C.a->ws + CW_QSEL;
    const int NU = BATCH * (NTILE - 4) * 4;
    for (;;) {
        if (C.tid == 0) MISC[16] = atomicAdd(qhead, 1u);
        __syncthreads();
        const int j = (int)MISC[16];
        __syncthreads();
        if (j >= NU) break;
        const int c = 32 - (j >> 6), b = (j & 63) >> 2, g = j & 3;
        select_unit<SCORE_F32>(C, b, c, g);
    }
}
}
#ifndef FAST_SEL
#define FAST_SEL 1
#endif

#ifndef SEL_F32
#define SEL_F32 0
#endif
namespace fa {
typedef short bf16x8 __attribute__((ext_vector_type(8)));
typedef short s16x4 __attribute__((ext_vector_type(4)));
typedef float f32x16 __attribute__((ext_vector_type(16)));
typedef short v4i16_t __attribute__((ext_vector_type(4)));
typedef float f32x2_t __attribute__((ext_vector_type(2))); typedef __bf16 bf16x2_t __attribute__((ext_vector_type(2)));
constexpr int L_K = 0, L_V = 16384, L_WS = 32768, L_ST = 36864;
constexpr float NEGB = -1.0e30f;
constexpr float THR = 8.0f;
__device__ __forceinline__ int crow(int r, int hi) { return (r & 3) + 8 * (r >> 2) + 4 * hi; }
__device__ __forceinline__ void glds16(const void* gsrc, unsigned lds_dst) { unsigned keep;
    asm volatile("s_mov_b32 %0, m0\n\ts_mov_b32 m0, %2\n\ts_nop 0\n\tglobal_load_lds_dwordx4 %1, off\n\ts_mov_b32 m0, %0" : "=&s"(keep) : "v"(gsrc), "s"(lds_dst) : "memory"); }
__device__ __forceinline__ unsigned cvtpk(float lo, float hi) { f32x2_t v = {lo, hi}; bf16x2_t b = __builtin_convertvector(v, bf16x2_t); return __builtin_bit_cast(unsigned, b); }
__device__ __forceinline__ float half_swap_max(float m) { auto rr = __builtin_amdgcn_permlane32_swap(__float_as_uint(m), __float_as_uint(m), false, false); return fmaxf(__uint_as_float(rr[0]), __uint_as_float(rr[1])); }
__device__ __forceinline__ float half_swap_sum(float m) { auto rr = __builtin_amdgcn_permlane32_swap(__float_as_uint(m), __float_as_uint(m), false, false); return __uint_as_float(rr[0]) + __uint_as_float(rr[1]); }

__device__ __forceinline__ void attn_unit(Ctx& C, int b, int h, int tile0, int nq, int NT) {
    const int lane = C.lane, r32 = lane & 31, hi = lane >> 5, wid = C.wave;
    const int qt = tile0 + (wid >> 1); const bool active = (wid >> 1) < nq;
    const int i = qt * 64 + (wid & 1) * 32 + r32;
    const bf16_t* P = WSP(bf16_t, WS_PROJ) + (size_t)b * TP * PC;
    const unsigned lds0 = (unsigned)(size_t)C.lds;
    LAS float* wsf = (LAS float*)(C.lds + L_WS) + wid * 128;
    LAS float* stg = (LAS float*)(C.lds + L_ST) + wid * 2048;
    const bf16_t* ksrc = P + (size_t)lane * PC + C_AK + h * 64 + wid * 8;
    const bf16_t* vsrc = P + (size_t)(16 * (wid & 3) + (lane >> 2)) * PC + C_AV + h * 64 + (wid >> 2) * 32 + (lane & 3) * 8;
    const unsigned kdst = lds0 + L_K + wid * 1024, vdst = lds0 + L_V + wid * 1024;
#define FA_DMA(t, slot) do { glds16(ksrc + (size_t)(t) * 64 * PC, (unsigned)__builtin_amdgcn_readfirstlane(kdst + (slot) * 8192)); \
                             glds16(vsrc + (size_t)(t) * 64 * PC, (unsigned)__builtin_amdgcn_readfirstlane(vdst + (slot) * 8192)); } while (0)
    const float slope2 = exp2f(-(float)(h + 1)) * LOG2E;
    const float fi = (float)i;
    bf16x8 qr[4];
#pragma unroll
    for (int d0 = 0; d0 < 4; ++d0) qr[d0] = *(const bf16x8*)(P + (size_t)i * PC + C_AQ + h * 64 + d0 * 16 + hi * 8);
    const u64* mrow = WSP(u64, WS_MASK) + ((size_t)b * TP + i) * NTILE;
    float m_run = -INFINITY, l_run = 0.f;
    f32x16 o[2]; o[0] = f32x16{}; o[1] = f32x16{};
    FA_DMA(0, 0);
    u64 mw_next = mrow[0];
    for (int t = 0; t < NT; ++t) {
        const int slot = t & 1;
        asm volatile("s_waitcnt vmcnt(0) lgkmcnt(0)\n\ts_barrier" ::: "memory");
        const u64 mw = mw_next;
        if (t + 1 < NT) { mw_next = (t + 1 <= qt) ? mrow[t + 1] : 0ull; FA_DMA(t + 1, slot ^ 1); }
        if (active && t <= qt) {
            f32x16 p0 = f32x16{}, p1 = f32x16{};
            { const LAS char* kb = (const LAS char*)C.lds + L_K + slot * 8192 + hi * 1024 + r32 * 16;
#pragma unroll
              for (int d0 = 0; d0 < 4; ++d0) { const bf16x8 b0 = *(const LAS bf16x8*)(kb + d0 * 2048), b1 = *(const LAS bf16x8*)(kb + d0 * 2048 + 512);
                  p0 = __builtin_amdgcn_mfma_f32_32x32x16_bf16(b0, qr[d0], p0, 0, 0, 0); p1 = __builtin_amdgcn_mfma_f32_32x32x16_bf16(b1, qr[d0], p1, 0, 0, 0); } }
            const unsigned wl = (unsigned)mw >> (4 * hi), wh = (unsigned)(mw >> 32) >> (4 * hi);
            float A0, A1;
            if (t == qt) {
                const float kbase = (float)(64 * t + 4 * hi);
#pragma unroll
                for (int r = 0; r < 16; ++r) { const int kc = (r & 3) + 8 * (r >> 2); const float kf = kbase + (float)kc;
                    const float b0_ = slope2 * (fi - fabsf(fi - kf)), b1_ = slope2 * (fi - fabsf(fi - (kf + 32.f)));
                    p0[r] = ((wl >> kc) & 1u) ? p0[r] + b0_ : NEGB; p1[r] = ((wh >> kc) & 1u) ? p1[r] + b1_ : NEGB; }
                A0 = 0.f; A1 = 0.f;
            } else {
#pragma unroll
                for (int r = 0; r < 16; ++r) { const int kc = (r & 3) + 8 * (r >> 2); const float cr = slope2 * (float)kc;
                    p0[r] = ((wl >> kc) & 1u) ? p0[r] + cr : NEGB; p1[r] = ((wh >> kc) & 1u) ? p1[r] + cr : NEGB; }
                A0 = slope2 * (float)(64 * t + 4 * hi); A1 = A0 + 32.f * slope2;
            }
            float mx0 = p0[0], mx1 = p1[0];
#pragma unroll
            for (int r = 1; r < 16; ++r) { mx0 = fmaxf(mx0, p0[r]); mx1 = fmaxf(mx1, p1[r]); }
            const float rm = half_swap_max(fmaxf(mx0 + A0, mx1 + A1));
            const bool need = rm > m_run + THR;
            if (__any(need)) {
                const float mnew = need ? rm : m_run;
                const float alpha = need ? exp2f(m_run - mnew) : 1.f;
                m_run = mnew; l_run *= alpha;
                if (hi == 0) wsf[r32] = alpha;
                LDS_WAIT();
#pragma unroll
                for (int r = 0; r < 16; ++r) { const float a = wsf[crow(r, hi)]; o[0][r] *= a; o[1][r] *= a; }
            }
            const float s0 = m_run - A0, s1 = m_run - A1;
            float sum = 0.f;
#pragma unroll
            for (int r = 0; r < 16; ++r) { p0[r] = __builtin_amdgcn_exp2f(p0[r] - s0); p1[r] = __builtin_amdgcn_exp2f(p1[r] - s1); sum += p0[r] + p1[r]; }
            l_run += half_swap_sum(sum);
            u32x4 pw0, pw1, pw2, pw3;
            pw0 = (u32x4){cvtpk(p0[0], p0[1]), cvtpk(p0[2], p0[3]), cvtpk(p0[4], p0[5]), cvtpk(p0[6], p0[7])};
            pw1 = (u32x4){cvtpk(p0[8], p0[9]), cvtpk(p0[10], p0[11]), cvtpk(p0[12], p0[13]), cvtpk(p0[14], p0[15])};
            pw2 = (u32x4){cvtpk(p1[0], p1[1]), cvtpk(p1[2], p1[3]), cvtpk(p1[4], p1[5]), cvtpk(p1[6], p1[7])};
            pw3 = (u32x4){cvtpk(p1[8], p1[9]), cvtpk(p1[10], p1[11]), cvtpk(p1[12], p1[13]), cvtpk(p1[14], p1[15])};
            const int vb = (int)(lds0 + L_V + slot * 8192) + ((lane >> 4) & 1) * 32 + (lane & 3) * 8 + (4 * hi + ((lane & 15) >> 2)) * 64;
#pragma unroll
            for (int d0 = 0; d0 < 2; ++d0) { s16x4 lo_[4], hi_[4];
#pragma unroll
                for (int ks = 0; ks < 4; ++ks) {
                    asm volatile("ds_read_b64_tr_b16 %0,%1 offset:%c2" : "=&v"(lo_[ks]) : "v"(vb), "i"(d0 * 4096 + ks * 1024) : "memory");
                    asm volatile("ds_read_b64_tr_b16 %0,%1 offset:%c2" : "=&v"(hi_[ks]) : "v"(vb), "i"(d0 * 4096 + ks * 1024 + 512) : "memory"); }
                asm volatile("s_waitcnt lgkmcnt(0)" ::: "memory"); __builtin_amdgcn_sched_barrier(0);
#define FA_PK(k) (bf16x8){lo_[k][0], lo_[k][1], lo_[k][2], lo_[k][3], hi_[k][0], hi_[k][1], hi_[k][2], hi_[k][3]}
                o[d0] = __builtin_amdgcn_mfma_f32_32x32x16_bf16(__builtin_bit_cast(bf16x8, pw0), FA_PK(0), o[d0], 0, 0, 0);
                o[d0] = __builtin_amdgcn_mfma_f32_32x32x16_bf16(__builtin_bit_cast(bf16x8, pw1), FA_PK(1), o[d0], 0, 0, 0);
                o[d0] = __builtin_amdgcn_mfma_f32_32x32x16_bf16(__builtin_bit_cast(bf16x8, pw2), FA_PK(2), o[d0], 0, 0, 0);
                o[d0] = __builtin_amdgcn_mfma_f32_32x32x16_bf16(__builtin_bit_cast(bf16x8, pw3), FA_PK(3), o[d0], 0, 0, 0);
#undef FA_PK
            }
        }
    }
    if (active) {
        if (hi == 0) wsf[32 + r32] = l_run;
        LDS_WAIT();
#pragma unroll
        for (int r = 0; r < 16; ++r) { const int orow = crow(r, hi); const float rl = 1.f / wsf[32 + orow];
            stg[orow * 64 + r32] = o[0][r] * rl; stg[orow * 64 + 32 + r32] = o[1][r] * rl; }
        LDS_WAIT();
        const float* gain = IN_(7) + h * 64;
#pragma unroll
        for (int it = 0; it < 4; ++it) { const int row = it * 8 + (lane >> 3), ch = lane & 7;
            const f32x4 v0 = *(const LAS f32x4*)(stg + row * 64 + ch * 8), v1 = *(const LAS f32x4*)(stg + row * 64 + ch * 8 + 4);
            float ss = (v0[0] * v0[0] + v0[1] * v0[1]) + (v0[2] * v0[2] + v0[3] * v0[3]) + (v1[0] * v1[0] + v1[1] * v1[1]) + (v1[2] * v1[2] + v1[3] * v1[3]);
            ss += __shfl_xor(ss, 1); ss += __shfl_xor(ss, 2); ss += __shfl_xor(ss, 4);
            const float rstd = 1.f / sqrtf(ss * (1.f / 64.f) + 1e-6f);
            const f32x4 g0 = *(const f32x4*)(gain + ch * 8), g1 = *(const f32x4*)(gain + ch * 8 + 4);
            const float w[8] = {v0[0] * rstd * g0[0], v0[1] * rstd * g0[1], v0[2] * rstd * g0[2], v0[3] * rstd * g0[3], v1[0] * rstd * g1[0], v1[1] * rstd * g1[1], v1[2] * rstd * g1[2], v1[3] * rstd * g1[3]};
            const int ii = qt * 64 + (wid & 1) * 32 + row;
            if (ii >= 64) store8_bf16(WSP(bf16_t, WS_MIXED) + ((size_t)b * SEQ + (ii - 64)) * DM + h * 64 + ch * 8, w);
            else if (ii >= 48) store8_bf16(WSP(bf16_t, WS_MIXM) + ((size_t)b * 16 + (ii - 48)) * DM + h * 64 + ch * 8, w);
        }
    }
    asm volatile("s_waitcnt vmcnt(0) lgkmcnt(0)\n\ts_barrier" ::: "memory");
#undef FA_DMA
}
__device__ __forceinline__ void phase_attn_fast(Ctx& C) {
    const int vcu = (C.G % 8 == 0) ? (C.bid % 8) * (C.G / 8) + C.bid / 8 : C.bid;
    for (int w = vcu; w < 256; w += C.G) {
        const int bh = w >> 1, par = w & 1, b = bh >> 3, h = bh & 7;
#pragma unroll 1
        for (int k = 0; k < 5; ++k) {
            if (k == 4 && par != 0) continue;
            const int u = (k == 0) ? (par ? 6 : 7) : (k == 1) ? (par ? 1 : 0) : (k == 2) ? (par ? 4 : 5) : (par ? 3 : 2);
            const int tile0 = (k == 4) ? 0 : 4 * u + 1, nq = (k == 4) ? 1 : 4, NT = (k == 4) ? 1 : 4 * u + 5;
            attn_unit(C, b, h, tile0, nq, NT);
        }
    }
    __syncthreads();
}
}
#ifndef FAST_ATTN
#define FAST_ATTN 1
#endif
__device__ __forceinline__ void job_y1m(Ctx& C) {
    const int gt = C.bid * NTHR + C.tid;
    if (gt < 2 * DM) { const int r = gt >> 10, n = gt & 1023; const bf16_t* mr = WSP(bf16_t, WS_MIXM) + (size_t)(14 + r) * DM; float acc = 0.f;
        for (int k = 0; k < DM; ++k) acc += bf2f(mr[k]) * IN_(9)[(size_t)k * DM + n];
        WSP(float, WS_Y1M)[r * DM + n] = ALPHA * WSP(float, WS_H0M)[(14 + r) * DM + n] + acc; }
}
__device__ __forceinline__ void job_ameta(Ctx& C) {
    const int gt = C.bid * NTHR + C.tid;
    if (gt < 2 * DFF) { const int r = gt / DFF, n = gt % DFF; const bf16_t* wr = WSP(bf16_t, WS_WUP) + (size_t)((n >> 7) * 256 + (n & 127)) * DM; const float* hr = WSP(float, WS_H1M) + r * DM; float acc = 0.f;
        for (int k = 0; k < DM; ++k) acc += hr[k] * bf2f(wr[k]);
        WSP(float, WS_AMETA)[r * DFF + n] = acc; }
}
__device__ __forceinline__ float gelu_tanh(float x) { const float u = 0.7978845608028654f * (x + 0.044715f * x * x * x); return 0.5f * x * (1.f + tanhf(u)); }
__device__ __forceinline__ void phase_conv(Ctx& C, int half) {
    const int gt = C.bid * NTHR + C.tid, NGT = C.G * NTHR;
    for (int it = gt; it < MR * 11 * 16; it += NGT) {
        const int r8 = it & 15, jj = (it >> 4) % 11, m = it / (16 * 11), s = m & 2047;
        const int na = (half * 11 + jj) * 128 + r8 * 8;
        const bf16_t* up = WSP(bf16_t, WS_U) + (size_t)m * DFF + jj * 256 + r8 * 8;
        const u32x4 a0 = *(const u32x4*)up, g0 = *(const u32x4*)(up + 128);
        float a[8], a1[8], a2[8], g[8];
        a[0] = bflo(a0.x); a[1] = bfhi(a0.x); a[2] = bflo(a0.y); a[3] = bfhi(a0.y); a[4] = bflo(a0.z); a[5] = bfhi(a0.z); a[6] = bflo(a0.w); a[7] = bfhi(a0.w);
        g[0] = bflo(g0.x); g[1] = bfhi(g0.x); g[2] = bflo(g0.y); g[3] = bfhi(g0.y); g[4] = bflo(g0.z); g[5] = bfhi(g0.z); g[6] = bflo(g0.w); g[7] = bfhi(g0.w);
        if (s >= 1) { const u32x4 t = *(const u32x4*)(up - DFF); a1[0] = bflo(t.x); a1[1] = bfhi(t.x); a1[2] = bflo(t.y); a1[3] = bfhi(t.y); a1[4] = bflo(t.z); a1[5] = bfhi(t.z); a1[6] = bflo(t.w); a1[7] = bfhi(t.w); }
        else {
#pragma unroll
            for (int j = 0; j < 8; ++j) a1[j] = WSP(float, WS_AMETA)[DFF + na + j]; }
        if (s >= 2) { const u32x4 t = *(const u32x4*)(up - 2 * DFF); a2[0] = bflo(t.x); a2[1] = bfhi(t.x); a2[2] = bflo(t.y); a2[3] = bfhi(t.y); a2[4] = bflo(t.z); a2[5] = bfhi(t.z); a2[6] = bflo(t.w); a2[7] = bfhi(t.w); }
        else {
#pragma unroll
            for (int j = 0; j < 8; ++j) a2[j] = WSP(float, WS_AMETA)[(s == 1 ? DFF : 0) + na + j]; }
        float o[8];
#pragma unroll
        for (int j = 0; j < 8; ++j) { const float cv = a2[j] * IN_(13)[na + j] + a1[j] * IN_(13)[DFF + na + j] + a[j] * IN_(13)[2 * DFF + na + j] + IN_(14)[na + j]; o[j] = gelu_tanh(cv) * g[j]; }
        store8_bf16(WSP(bf16_t, WS_ACT) + (size_t)m * DFF + na, o);
    }
}

constexpr int LDS_BYTES = 147456;
constexpr int MISC_OFF = 147456 - 256;
constexpr int N_PHASES = 13;

__global__ void __launch_bounds__(NTHR, 2) fwd_kernel(Args args) {
    extern __shared__ __attribute__((aligned(16))) unsigned char lds[];
    Ctx C;
    C.lds = (LAS unsigned char*)lds;
    C.tid = threadIdx.x; C.lane = C.tid & 63; C.wave = __builtin_amdgcn_readfirstlane(C.tid >> 6); C.bid = blockIdx.x; C.G = gridDim.x;
    unsigned char* ws = args.ws; C.a = &args;
    volatile LAS unsigned* MISC = (volatile LAS unsigned*)(C.lds + MISC_OFF);
    if (C.tid < 32) MISC[C.tid] = 0u;
    __syncthreads();
    XcdBarrier bar = xcd_barrier_post((unsigned*)(ws + WS_CTL) + CW_BAR, MISC + 8);
    const int lo = args.ph_lo, hi = args.ph_hi;
#ifndef PHMASK
#define PHMASK 0xFFFFFFFFu
#endif
#define IN(k) (((PHMASK >> (k)) & 1u) && lo <= (k) && (k) < hi)
#ifndef TIME_PHASE
#define TIME_PHASE -1
#endif
#ifndef TSCALE
#define TSCALE 0.02f
#endif
    unsigned long long tp0 = (TIME_PHASE == 0) ? __builtin_amdgcn_s_memrealtime() : 0ull, tp1 = 0ull;
#define SEAM(k) do { if (IN(k) && IN((k) + 1)) xcd_barrier(bar); if (TIME_PHASE >= 0 && (((k) + 1 == TIME_PHASE && TIME_PHASE != 8) || ((k) == 7 && TIME_PHASE == 11) || ((k) == 3 && TIME_PHASE == 8))) tp0 = __builtin_amdgcn_s_memrealtime(); if (TIME_PHASE >= 0 && (k) == TIME_PHASE) tp1 = __builtin_amdgcn_s_memrealtime(); } while (0)
    const int gw = C.bid * NWAVES + C.wave, NGW = C.G * NWAVES;

    if (IN(0)) { phase_prologue(C); } SEAM(0);
    if (IN(1)) { phase_meta(C); } SEAM(1);
    if (IN(2)) { EpiProj E{WSP(bf16_t, WS_PROJ)}; GEMM_CALL(C, WSP(bf16_t, WS_H0), WSP(bf16_t, WS_WIN), MR, PC, DM, E);
#if PROBE_F32IDX
        naive_idx_gemm(C);
#endif
    } SEAM(2);
    if (IN(3)) {
#if !defined(NO_GLA) && !GLA_SEP
#if FAST_GLA
        for (int un = C.bid; un < BATCH * 4; un += C.G) gla::gla_unit(C, un >> 2, un & 3);
#else
        for (int un = C.bid; un < BATCH * 4; un += C.G) gla_naive_unit(C, un >> 2, un & 3);
#endif
#endif
#ifndef NO_SEL
#if FAST_SEL
        sel::phase_select_fast<SEL_F32 != 0>(C, MISC);
#else
        phase_select_naive(C);
#endif
#endif
    } SEAM(3);
#if GLA_SEP
    if (IN(8)) { for (int un = C.bid; un < BATCH * 4; un += C.G) gla::gla_unit(C, un >> 2, un & 3); } SEAM(8);
#endif
#if FAST_ATTN
    if (IN(4)) { fa::phase_attn_fast(C); } SEAM(4);
#else
    if (IN(4)) { phase_attn_naive(C); } SEAM(4);
#endif
#if FUSE_LN
    if (IN(5)) { job_y1m_fast(C); EpiYB E{WSP(bf16_t, WS_Y1B), WSP(bf16_t, WS_H0)}; fast_gemm(C, WSP(bf16_t, WS_MIXED), WSP(bf16_t, WS_WOUT), MR, DM, DM, E); } SEAM(5);
    if (IN(6)) { for (int m = gw; m < MR + 2; m += NGW) { if (m < MR) ln_row_b<true>(WSP(bf16_t, WS_Y1B) + (size_t)m * DM, IN_(10), IN_(11), WSP(bf16_t, WS_H1) + (size_t)m * DM, C.lane);
                                                           else ln_row<false>(WSP(float, WS_Y1M) + (size_t)(m - MR) * DM, IN_(10), IN_(11), WSP(float, WS_H1M) + (size_t)(m - MR) * DM, C.lane); } } SEAM(6);
    if (IN(7)) { job_ameta_fast2(C);
        pg8::Gemm g{WSP(bf16_t, WS_H1), WSP(bf16_t, WS_WUP), MR, NUP, DM}; pg8::StaticOrder S; S.init(MR, NUP, C.G, C.bid);
        EpiUpConv E{WSP(bf16_t, WS_ACT), WSP(float, WS_FIX), WSP(float, WS_HALO), IN_(13), IN_(14), (LAS float*)(C.lds + 131072), nullptr, nullptr};
        pg8::gemm_phase<EpiUpConv, pg8::StaticOrder, true, true>((PG8_LAS unsigned char*)C.lds, g, S, E); __syncthreads(); } SEAM(7);
    if (IN(11)) { { pg8::StaticOrder S; S.init(MR, DM, C.G, C.bid); pg8::Unit u; for (int i = 0; S.next(i, u); ++i) fix_rows(C, u.pm); }
        asm volatile("s_waitcnt vmcnt(0)" ::: "memory"); __syncthreads();
        EpiYB E{WSP(bf16_t, WS_Y2B), WSP(bf16_t, WS_H1)}; fast_gemm(C, WSP(bf16_t, WS_ACT), WSP(bf16_t, WS_WDN), MR, DM, DFF, E); } SEAM(11);
    if (IN(12)) { for (int m = gw; m < MR; m += NGW) ln_row_b<false>(WSP(bf16_t, WS_Y2B) + (size_t)m * DM, IN_(16), IN_(17), C.a->out + (size_t)m * DM, C.lane); }
#else
    if (IN(5)) { job_y1m(C); EpiY E{WSP(float, WS_Y1), WSP(bf16_t, WS_H0)}; GEMM_CALL(C, WSP(bf16_t, WS_MIXED), WSP(bf16_t, WS_WOUT), MR, DM, DM, E); } SEAM(5);
    if (IN(6)) { for (int m = gw; m < MR + 2; m += NGW) { if (m < MR) ln_row<true>(WSP(float, WS_Y1) + (size_t)m * DM, IN_(10), IN_(11), WSP(bf16_t, WS_H1) + (size_t)m * DM, C.lane);
                                                           else ln_row<false>(WSP(float, WS_Y1M) + (size_t)(m - MR) * DM, IN_(10), IN_(11), WSP(float, WS_H1M) + (size_t)(m - MR) * DM, C.lane); } } SEAM(6);
#if FUSE_CONV
    if (IN(7)) { job_ameta(C);
        pg8::Gemm g{WSP(bf16_t, WS_H1), WSP(bf16_t, WS_WUP), MR, NUP, DM}; pg8::StaticOrder S; S.init(MR, NUP, C.G, C.bid);
        EpiUpConv E{WSP(bf16_t, WS_ACT), WSP(float, WS_FIX), WSP(float, WS_HALO), IN_(13), IN_(14), (LAS float*)(C.lds + 131072), nullptr, nullptr};
        pg8::gemm_phase<EpiUpConv, pg8::StaticOrder, true, true>((PG8_LAS unsigned char*)C.lds, g, S, E); __syncthreads(); } SEAM(7);
    if (IN(11)) { { pg8::StaticOrder S; S.init(MR, DM, C.G, C.bid); pg8::Unit u; for (int i = 0; S.next(i, u); ++i) fix_rows(C, u.pm); }
        asm volatile("s_waitcnt vmcnt(0)" ::: "memory"); __syncthreads();
        EpiY E{WSP(float, WS_Y2), WSP(bf16_t, WS_H1)}; GEMM_CALL(C, WSP(bf16_t, WS_ACT), WSP(bf16_t, WS_WDN), MR, DM, DFF, E); } SEAM(11);
#else
    if (IN(7)) { job_ameta(C); EpiU E{WSP(bf16_t, WS_U)}; GEMM_CALL(C, WSP(bf16_t, WS_H1), WSP(bf16_t, WS_WUP), MR, DFF, DM, E); } SEAM(7);
    if (IN(8)) { phase_conv(C, 0); } SEAM(8);
    if (IN(9)) { EpiU E{WSP(bf16_t, WS_U)}; GEMM_CALL(C, WSP(bf16_t, WS_H1), WSP(bf16_t, WS_WUP) + (size_t)DFF * DM, MR, DFF, DM, E); } SEAM(9);
    if (IN(10)) { phase_conv(C, 1); } SEAM(10);
    if (IN(11)) { EpiY E{WSP(float, WS_Y2), WSP(bf16_t, WS_H1)}; GEMM_CALL(C, WSP(bf16_t, WS_ACT), WSP(bf16_t, WS_WDN), MR, DM, DFF, E); } SEAM(11);
#endif
    if (IN(12)) { for (int m = gw; m < MR; m += NGW) ln_row<false>(WSP(float, WS_Y2) + (size_t)m * DM, IN_(16), IN_(17), (C.a->out) + (size_t)m * DM, C.lane); }
#endif
#if ITER_PROBE
    if (C.bid == 0 && C.tid == 0) { asm volatile("s_waitcnt vmcnt(0)" ::: "memory"); C.a->out[0] += 0.5f * (float)(*((volatile unsigned*)C.a->ws + 96)) / 29696.f; }
#endif
    if (TIME_PHASE >= 0) { if (TIME_PHASE == 12) tp1 = __builtin_amdgcn_s_memrealtime(); if (C.bid == 0 && C.tid == 0) { asm volatile("s_waitcnt vmcnt(0)" ::: "memory"); C.a->out[0] += TSCALE * 0.01f * (float)(tp1 - tp0); } }
#undef IN
#undef SEAM
}

#ifndef MK_SPLIT
#define MK_SPLIT 0
#endif
extern "C" void kernel_launch(void* const* d_in, const int* in_sizes, int n_in, void* d_out, int out_size, void* d_ws, size_t ws_size, hipStream_t stream) {
    static int grid = 0;
    if (grid == 0) {
        if (n_in != 18 || out_size != MR * DM || ws_size < WS_END) { fprintf(stderr, "kernel_launch: unexpected problem (n_in %d out %d ws %zu)\n", n_in, out_size, ws_size); grid = -1; return; }
        int dev = 0, cus = 0;
        if (hipGetDevice(&dev) != hipSuccess || hipDeviceGetAttribute(&cus, hipDeviceAttributeMultiprocessorCount, dev) != hipSuccess) { grid = -1; return; }
        if (hipFuncSetAttribute((const void*)fwd_kernel, hipFuncAttributeMaxDynamicSharedMemorySize, LDS_BYTES) != hipSuccess) { fprintf(stderr, "kernel_launch: hipFuncSetAttribute failed\n"); grid = -1; return; }
        int per_cu = 0;
        if (hipOccupancyMaxActiveBlocksPerMultiprocessor(&per_cu, (const void*)fwd_kernel, NTHR, LDS_BYTES) != hipSuccess || per_cu < 1) fprintf(stderr, "kernel_launch: occupancy query says %d\n", per_cu);
        (void)hipGetLastError();
        grid = cus;
    }
    if (grid < 0) return;
    (void)hipMemsetAsync((char*)d_ws + WS_CTL, 0, CTL_ZERO_BYTES, stream);
    Args a{};
    for (int i = 0; i < 18; ++i) a.in[i] = (const float*)d_in[i];
    a.out = (float*)d_out; a.ws = (unsigned char*)d_ws;
#if MK_SPLIT
    for (int p = 0; p < N_PHASES; ++p) { a.ph_lo = p; a.ph_hi = p + 1; hipLaunchKernelGGL(fwd_kernel, dim3(grid), dim3(NTHR), LDS_BYTES, stream, a); }
#else
    a.ph_lo = 0; a.ph_hi = N_PHASES;
    hipLaunchKernelGGL(fwd_kernel, dim3(grid), dim3(NTHR), LDS_BYTES, stream, a);
#endif
}
```

```cpp
#include <hip/hip_runtime.h>
#include <cstdio>
#include <cstdint>

#define LAS __attribute__((address_space(3)))
#define GAS __attribute__((address_space(1)))
typedef unsigned short bf16_t;
typedef float f32x4 __attribute__((ext_vector_type(4)));
typedef unsigned u32x4 __attribute__((ext_vector_type(4)));
typedef unsigned long long u64;

constexpr int BATCH = 16, SEQ = 2048, DM = 1024, NMETA = 16;
constexpr int NTILE = 33, TP = NTILE * 64;
constexpr int MR = BATCH * SEQ;
constexpr int PC = 3584;
constexpr int C_AQ = 0, C_AK = 512, C_AV = 1024, C_BQ = 1536, C_BK = 1792, C_BV = 2048, C_OG = 2560, C_IQ = 3072, C_IK = 3328, C_LR = 3392, C_IW = 3408, C_END = 3412, C_SPLIT = 3072;
constexpr int DFF = 2816, NUP = 2 * DFF;
constexpr int TOPK = 256;
constexpr float ALPHA = 1.189207115002721f;
constexpr float LOG2E = 1.4426950408889634f;
constexpr float QSCALE = 0.125f * LOG2E;
constexpr int NWAVES = 8, NTHR = 512;

constexpr size_t MiB = 1u << 20;
constexpr size_t WS_CTL = 0, CTL_ZERO_BYTES = 1 * MiB;
constexpr size_t WS_H0M = 1 * MiB;
constexpr size_t WS_Y1M = WS_H0M + 65536;
constexpr size_t WS_H1M = WS_Y1M + 8192;
constexpr size_t WS_AMETA = WS_H1M + 8192;
constexpr size_t WS_MIXM = 2 * MiB;
constexpr size_t WS_WIN = 4 * MiB;
constexpr size_t WS_WOUT = 12 * MiB;
constexpr size_t WS_WUP = 14 * MiB;
constexpr size_t WS_WDN = 25 * MiB;
constexpr size_t WS_H0 = 32 * MiB;
constexpr size_t WS_H1 = 32 * MiB;
constexpr size_t WS_MASK = 96 * MiB;
constexpr size_t WS_MIXED = 112 * MiB;
constexpr size_t WS_PROJ = 176 * MiB;
constexpr size_t WS_Y1 = 176 * MiB;
constexpr size_t WS_U = 96 * MiB;
constexpr size_t WS_ACT = 272 * MiB;
constexpr size_t WS_Y2 = 96 * MiB;
constexpr size_t WS_IDX = 408 * MiB;
constexpr size_t WS_STAT = 3 * MiB;
constexpr size_t WS_WIN8 = 4 * MiB, WS_WINB = 7 * MiB, WS_WOUT8 = 12 * MiB, WS_WUP8 = 14 * MiB, WS_WDN8 = 25 * MiB;
constexpr size_t WS_MIX8 = 112 * MiB, WS_H1Q = 240 * MiB, WS_ACT8 = 272 * MiB;
constexpr size_t WS_H0Q = 408 * MiB;
constexpr size_t WS_FIX = 464 * MiB;
constexpr size_t WS_HALO = 470 * MiB;
constexpr size_t WS_END = 476 * MiB;
#ifndef PROBE_F32IDX
#define PROBE_F32IDX 0
#endif
constexpr int CW_BAR = 4096;
constexpr size_t WS_C12 = 64 * 1024;
constexpr size_t WS_ST1 = 128 * 1024;
constexpr size_t WS_ST2 = 512 * 1024;
constexpr size_t WS_Y1B = 176 * MiB;
constexpr size_t WS_Y2B = 96 * MiB;

__device__ __forceinline__ float bf2f(bf16_t v) { return __uint_as_float((unsigned)v << 16); }
__device__ __forceinline__ float bflo(unsigned u) { return __uint_as_float(u << 16); }
__device__ __forceinline__ float bfhi(unsigned u) { return __uint_as_float(u & 0xffff0000u); }
__device__ __forceinline__ unsigned f2bf(float f) { unsigned u = __float_as_uint(f); return (u + 0x7fffu + ((u >> 16) & 1u)) >> 16; }
__device__ __forceinline__ unsigned pk2(float lo, float hi) { return f2bf(lo) | (f2bf(hi) << 16); }
__device__ __forceinline__ float wave_sum(float v) {
#pragma unroll
    for (int o = 1; o < 64; o <<= 1) v += __shfl_xor(v, o);
    return v;
}
__device__ __forceinline__ float wave_max(float v) {
#pragma unroll
    for (int o = 1; o < 64; o <<= 1) v = fmaxf(v, __shfl_xor(v, o));
    return v;
}
#define LDS_WAIT() asm volatile("s_waitcnt lgkmcnt(0)" ::: "memory")


#ifndef EMU_FP8
#define EMU_FP8 0
#endif
#ifndef EMU_FP8_IN
#define EMU_FP8_IN 0
#endif
#ifndef EMU_FP8_OUT
#define EMU_FP8_OUT 0
#endif
constexpr float S_H1 = 16.f, S_WUP = 64.f, S_ACT = 8.f, S_WDN = 64.f, S_H0 = 16.f, S_WIN = 64.f, S_MIX = 16.f, S_WOUT = 64.f;
#ifndef USE_FP8
#define USE_FP8 1
#endif
__device__ __forceinline__ float clamp8(float x) { return __builtin_fminf(__builtin_fmaxf(x, -448.f), 448.f); }
__device__ __forceinline__ unsigned pk4_f8(float a, float b, float c, float d, float sc) {
    int p = __builtin_amdgcn_cvt_pk_fp8_f32(clamp8(a * sc), clamp8(b * sc), 0, false); p = __builtin_amdgcn_cvt_pk_fp8_f32(clamp8(c * sc), clamp8(d * sc), p, true); return (unsigned)p; }
__device__ __forceinline__ float f8dot4(unsigned w, float a, float b, float c, float d) {
    return __builtin_amdgcn_cvt_f32_fp8((int)w, 0) * a + __builtin_amdgcn_cvt_f32_fp8((int)w, 1) * b + __builtin_amdgcn_cvt_f32_fp8((int)w, 2) * c + __builtin_amdgcn_cvt_f32_fp8((int)w, 3) * d; }
constexpr int E_W = 121, E_A16 = 123, E_A8 = 124;
__device__ __forceinline__ float q8(float x, float sc) {
    const float y = fminf(fmaxf(x * sc, -448.f), 448.f); const int p = __builtin_amdgcn_cvt_pk_fp8_f32(y, y, 0, false); return __builtin_amdgcn_cvt_f32_fp8(p, 0) / sc; }
#define XB_TMO      128
#define XB_XCNT(j)  (256  + 64 * (j))
#define XB_XSUB(j)  (1280 + 64 * (j))
#define XB_XGEN(j)  (2304 + 64 * (j))
#define XB_TOP      3328
#define XB_TOPGEN   3392
#define XCD_BAR_WORDS 3456
#define XB_SPIN_CAP (1u << 22)
__device__ __forceinline__ unsigned xb_ld(unsigned* p)              { return __hip_atomic_load(p, __ATOMIC_RELAXED, __HIP_MEMORY_SCOPE_AGENT); }
__device__ __forceinline__ unsigned xb_add(unsigned* p, unsigned v) { return __hip_atomic_fetch_add(p, v, __ATOMIC_RELAXED, __HIP_MEMORY_SCOPE_AGENT); }
__device__ __forceinline__ unsigned xb_xcc_id() { return (unsigned)__builtin_amdgcn_s_getreg((3 << 11) | 20) & 0xFu; }
#define XB_SPIN(cond, bar) do { unsigned _sp = 0; while (cond) { __builtin_amdgcn_s_sleep(1); \
    if ((++_sp & 255u) == 0u) { if (xb_ld(&(bar)[XB_TMO])) break; if (_sp > XB_SPIN_CAP) { atomicAdd(&(bar)[XB_TMO], 1u); break; } } } } while (0)
struct XcdBarrier { unsigned* bar; unsigned x; volatile LAS unsigned* st; };
__device__ __forceinline__ XcdBarrier xcd_barrier_post(unsigned* bar, volatile LAS unsigned* st) {
    XcdBarrier b; b.bar = bar; b.x = xb_xcc_id(); b.st = st;
    if (threadIdx.x == 0) (void)xb_add(&bar[XB_XCNT(b.x)], 1u);
    return b;
}
__device__ __forceinline__ void xcd_barrier_complete(unsigned* bar, unsigned x, unsigned& nloc, unsigned& nx) {
    const unsigned G = gridDim.x * gridDim.y * gridDim.z;
    unsigned sum, cnt, mine, sp = 0u;
    for (;;) {
        sum = 0u; cnt = 0u; mine = 0u;
#pragma unroll
        for (unsigned j = 0; j < 16; ++j) { const unsigned c = xb_ld(&bar[XB_XCNT(j)]); sum += c; cnt += (c > 0u) ? 1u : 0u; mine = (j == x) ? c : mine; }
        if (sum == G) break;
        __builtin_amdgcn_s_sleep(1);
        if ((++sp & 255u) == 0u) { if (xb_ld(&bar[XB_TMO])) break; if (sp > XB_SPIN_CAP) { atomicAdd(&bar[XB_TMO], 1u); break; } }
    }
    nloc = mine > 0u ? mine : 1u; nx = cnt > 0u ? cnt : 1u;
}
__device__ __forceinline__ void xcd_barrier(const XcdBarrier& b) {
    asm volatile("s_waitcnt vmcnt(0)" ::: "memory");
    __syncthreads();
    if (threadIdx.x == 0) {
        unsigned* bar = b.bar;
        __builtin_amdgcn_s_waitcnt(0);
        unsigned nloc = b.st[0], nx = b.st[1];
        if (nloc == 0u) { xcd_barrier_complete(bar, b.x, nloc, nx); b.st[0] = nloc; b.st[1] = nx; }
        const unsigned old = xb_add(&bar[XB_XSUB(b.x)], 1u);
        const unsigned gen = old / nloc;
        if (old + 1u == (gen + 1u) * nloc) {
            __builtin_amdgcn_fence(__ATOMIC_RELEASE, "agent");
            asm volatile("s_waitcnt vmcnt(0)" ::: "memory");
            const unsigned og = xb_add(&bar[XB_TOP], 1u);
            const unsigned tg = og / nx;
            if (og + 1u == (tg + 1u) * nx) xb_add(&bar[XB_TOPGEN], 1u);
            else XB_SPIN(xb_ld(&bar[XB_TOPGEN]) == tg, bar);
            __builtin_amdgcn_fence(__ATOMIC_ACQUIRE, "agent");
            xb_add(&bar[XB_XGEN(b.x)], 1u);
            asm volatile("s_waitcnt vmcnt(0)" ::: "memory");
        } else {
            XB_SPIN(xb_ld(&bar[XB_XGEN(b.x)]) == gen, bar);
            __builtin_amdgcn_fence(__ATOMIC_ACQUIRE, "agent");
            asm volatile("s_waitcnt vmcnt(0)" ::: "memory");
        }
    }
    __syncthreads();
}

struct Args { const float* in[18]; float* out; unsigned char* ws; int ph_lo, ph_hi; };
struct Ctx {
    const Args* a;
    LAS unsigned char* lds;
    int tid, lane, wave, bid, G;
};
#define WSP(T, off) ((T*)(C.a->ws + (off)))
#define IN_(k) (C.a->in[k])

__device__ __forceinline__ int src_col_in(int n) {
    if (n < 1536) return n;
    if (n < 2048) return 1860 + (n - 1536);
    if (n < 2560) return 2372 + (n - 2048);
    if (n < 3072) return 2900 + (n - 2560);
    if (n < 3328) return 1536 + (n - 3072);
    if (n < 3392) return 1792 + (n - 3328);
    if (n < 3408) return 2884 + (n - 3392);
    if (n < 3412) return 1856 + (n - 3408);
    return -1;
}
__device__ __forceinline__ int src_col_up(int n) { const int j = n >> 8, r = n & 255; return r < 128 ? 128 * j + r : DFF + 128 * j + (r - 128); }
template <int MAP> __device__ __forceinline__ void transpose_item(const float* W, int K, int Nsrc, int Ndst, bf16_t* WT, LAS float* scr, int item, int lane, const float* gam = nullptr, const float* bet = nullptr, float* c12 = nullptr) {
    const int nblk = Ndst / 32, kb = item / nblk, nb = item % nblk, k0 = 64 * kb, n0 = 32 * nb;
    const int nd = n0 + (lane & 31);
    const int sc = MAP == 1 ? src_col_in(nd) : (MAP == 2 ? src_col_up(nd) : nd);
    float s1 = 0.f, s2 = 0.f;
#pragma unroll 8
    for (int i = 0; i < 32; ++i) { const int kk = 2 * i + (lane >> 5); float w = sc >= 0 ? W[(size_t)(k0 + kk) * Nsrc + sc] : 0.f;
        if (MAP == 2 && gam) { s2 += bet[k0 + kk] * w; w *= gam[k0 + kk]; s1 += __uint_as_float(f2bf(w) << 16); }
        if (EMU_FP8 && MAP == 2) w = q8(w, S_WUP);
        if (EMU_FP8 && MAP == 3) w = q8(w, S_WDN);
        if (EMU_FP8_IN && MAP == 1 && nd < C_SPLIT) w = q8(w, S_WIN);
        if (EMU_FP8_OUT && MAP == 4) w = q8(w, S_WOUT);
        scr[kk * 33 + (lane & 31)] = w; }
    if (MAP == 2 && gam) { s1 += __shfl_xor(s1, 32); s2 += __shfl_xor(s2, 32); if (lane < 32) { atomicAdd(c12 + nd, s1); atomicAdd(c12 + NUP + nd, s2); } }
    LDS_WAIT(); asm volatile("" ::: "memory");
    const int c = lane & 7;
#pragma unroll
    for (int j = 0; j < 4; ++j) { const int n = (lane >> 3) + 8 * j; const LAS float* s = scr + (8 * c) * 33 + n;
        u32x4 o; o.x = pk2(s[0 * 33], s[1 * 33]); o.y = pk2(s[2 * 33], s[3 * 33]); o.z = pk2(s[4 * 33], s[5 * 33]); o.w = pk2(s[6 * 33], s[7 * 33]);
        *(u32x4*)(WT + (size_t)(n0 + n) * K + k0 + 8 * c) = o; }
    LDS_WAIT(); asm volatile("" ::: "memory");
}

template <int MAP> __device__ __forceinline__ void transpose_item_f8(const float* W, int K, int Nsrc, int Ndst, unsigned char* WT, LAS float* scr, int item, int lane, float sc8) {
    const int nblk = Ndst / 32, kb = item / nblk, nb = item % nblk, k0 = 64 * kb, n0 = 32 * nb;
    const int nd = n0 + (lane & 31);
    const int sc = MAP == 1 ? src_col_in(nd) : (MAP == 2 ? src_col_up(nd) : nd);
#pragma unroll 8
    for (int i = 0; i < 32; ++i) { const int kk = 2 * i + (lane >> 5); scr[kk * 33 + (lane & 31)] = sc >= 0 ? W[(size_t)(k0 + kk) * Nsrc + sc] : 0.f; }
    LDS_WAIT(); asm volatile("" ::: "memory");
    const int kc = (lane & 3) * 16;
#pragma unroll
    for (int j = 0; j < 2; ++j) { const int n = (lane >> 2) + 16 * j; const LAS float* p = scr + kc * 33 + n;
        u32x4 o; o.x = pk4_f8(p[0], p[33], p[66], p[99], sc8); o.y = pk4_f8(p[132], p[165], p[198], p[231], sc8); o.z = pk4_f8(p[264], p[297], p[330], p[363], sc8); o.w = pk4_f8(p[396], p[429], p[462], p[495], sc8);
        *(u32x4*)(WT + (size_t)(n0 + n) * K + k0 + kc) = o; }
    LDS_WAIT(); asm volatile("" ::: "memory");
}
template <bool OUT_BF16> __device__ __forceinline__ void ln_row(const float* xrow, const float* g, const float* bt, void* orow, int lane, float* stat = nullptr) {
    const f32x4* xr = (const f32x4*)xrow + lane;
    f32x4 v[4]; float s = 0.f;
#pragma unroll
    for (int j = 0; j < 4; ++j) { v[j] = xr[64 * j]; s += (v[j].x + v[j].y) + (v[j].z + v[j].w); }
    const float mean = wave_sum(s) * (1.f / DM); float s2 = 0.f;
#pragma unroll
    for (int j = 0; j < 4; ++j) { v[j] = v[j] - mean; s2 += (v[j].x * v[j].x + v[j].y * v[j].y) + (v[j].z * v[j].z + v[j].w * v[j].w); }
    const float rstd = 1.f / sqrtf(wave_sum(s2) * (1.f / DM) + 1e-5f);
    if (stat && lane == 0) { stat[0] = mean; stat[1] = rstd; }
#pragma unroll
    for (int j = 0; j < 4; ++j) {
        const f32x4 gg = ((const f32x4*)g)[lane + 64 * j], bb = ((const f32x4*)bt)[lane + 64 * j];
        const f32x4 o = v[j] * rstd * gg + bb;
        if (OUT_BF16) { u64 w = (u64)pk2(o.x, o.y) | ((u64)pk2(o.z, o.w) << 32); ((u64*)orow)[lane + 64 * j] = w; }
        else ((f32x4*)orow)[lane + 64 * j] = o;
    }
}
__device__ __forceinline__ void ln_row4(const float* x0, const float* g, const float* bt, bf16_t* o0, int lane, bf16_t* oq = nullptr) {
    f32x4 v[4][4]; float sm[4], sq[4];
#pragma unroll
    for (int r = 0; r < 4; ++r)
#pragma unroll
        for (int j = 0; j < 4; ++j) v[r][j] = ((const f32x4*)(x0 + (size_t)r * DM))[lane + 64 * j];
#pragma unroll
    for (int r = 0; r < 4; ++r) { sm[r] = 0.f;
#pragma unroll
        for (int j = 0; j < 4; ++j) sm[r] += (v[r][j].x + v[r][j].y) + (v[r][j].z + v[r][j].w); }
#pragma unroll
    for (int o = 1; o < 64; o <<= 1) {
#pragma unroll
        for (int r = 0; r < 4; ++r) sm[r] += __shfl_xor(sm[r], o); }
#pragma unroll
    for (int r = 0; r < 4; ++r) { const float mean = sm[r] * (1.f / DM); sq[r] = 0.f;
#pragma unroll
        for (int j = 0; j < 4; ++j) { v[r][j] = v[r][j] - mean; sq[r] += (v[r][j].x * v[r][j].x + v[r][j].y * v[r][j].y) + (v[r][j].z * v[r][j].z + v[r][j].w * v[r][j].w); } }
#pragma unroll
    for (int o = 1; o < 64; o <<= 1) {
#pragma unroll
        for (int r = 0; r < 4; ++r) sq[r] += __shfl_xor(sq[r], o); }
#pragma unroll
    for (int j = 0; j < 4; ++j) { const f32x4 gg = ((const f32x4*)g)[lane + 64 * j], bb = ((const f32x4*)bt)[lane + 64 * j];
#pragma unroll
        for (int r = 0; r < 4; ++r) { const float rstd = 1.f / sqrtf(sq[r] * (1.f / DM) + 1e-5f); const f32x4 a = v[r][j] * rstd * gg + bb;
            ((u64*)(o0 + (size_t)r * DM))[lane + 64 * j] = (u64)pk2(a.x, a.y) | ((u64)pk2(a.z, a.w) << 32);
            if (USE_FP8 && oq) ((unsigned*)((unsigned char*)oq + (size_t)r * DM))[lane + 64 * j] = pk4_f8(a.x, a.y, a.z, a.w, 16.f);
            else if (EMU_FP8_IN && oq) ((u64*)(oq + (size_t)r * DM))[lane + 64 * j] = (u64)pk2(q8(a.x, S_H0), q8(a.y, S_H0)) | ((u64)pk2(q8(a.z, S_H0), q8(a.w, S_H0)) << 32); } }
}
__device__ __forceinline__ float proj_scale(int n);
__device__ __forceinline__ void meta_proj_block(Ctx& C, int cb) {
    LAS float* hm = (LAS float*)C.lds;
    LAS float* red = hm + 16 * DM;
    const int lane = C.lane, wid = C.wave;
    __syncthreads();
#pragma unroll 1
    for (int r = 0; r < 2; ++r) { const int p = wid * 2 + r; const f32x4* xr = (const f32x4*)(IN_(1) + (size_t)p * DM) + lane;
        f32x4 v[4]; float sm = 0.f;
#pragma unroll
        for (int j = 0; j < 4; ++j) { v[j] = xr[64 * j]; sm += (v[j].x + v[j].y) + (v[j].z + v[j].w); }
        const float mean = wave_sum(sm) * (1.f / DM); float sq = 0.f;
#pragma unroll
        for (int j = 0; j < 4; ++j) { v[j] = v[j] - mean; sq += (v[j].x * v[j].x + v[j].y * v[j].y) + (v[j].z * v[j].z + v[j].w * v[j].w); }
        const float rstd = 1.f / sqrtf(wave_sum(sq) * (1.f / DM) + 1e-5f);
#pragma unroll
        for (int j = 0; j < 4; ++j) { const f32x4 gg = ((const f32x4*)IN_(2))[lane + 64 * j], bb = ((const f32x4*)IN_(3))[lane + 64 * j]; const f32x4 o = v[j] * rstd * gg + bb;
            *(LAS f32x4*)(hm + p * DM + 4 * (lane + 64 * j)) = o; if (cb == 0) *(f32x4*)(WSP(float, WS_H0M) + p * DM + 4 * (lane + 64 * j)) = o; } }
    __syncthreads();
    const int n = cb * 64 + lane, sc = src_col_in(n);
    float acc[16];
#pragma unroll
    for (int p = 0; p < 16; ++p) acc[p] = 0.f;
    if (sc >= 0) {
        const float* wp = IN_(4) + (size_t)(wid * 128) * C_END + sc;
#pragma unroll 1
        for (int k4 = 0; k4 < 128; k4 += 4) {
            const float w0 = wp[(size_t)(k4 + 0) * C_END], w1 = wp[(size_t)(k4 + 1) * C_END], w2 = wp[(size_t)(k4 + 2) * C_END], w3 = wp[(size_t)(k4 + 3) * C_END];
#pragma unroll
            for (int p = 0; p < 16; ++p) { const f32x4 h = *(const LAS f32x4*)(hm + p * DM + wid * 128 + k4); acc[p] += (h[0] * w0 + h[1] * w1) + (h[2] * w2 + h[3] * w3); }
        }
    }
#pragma unroll
    for (int p = 0; p < 16; ++p) red[(wid * 16 + p) * 64 + lane] = acc[p];
    __syncthreads();
#pragma unroll 1
    for (int r = 0; r < 2; ++r) { const int p = (C.tid >> 6) + 8 * r; float sm = 0.f;
#pragma unroll
        for (int w2 = 0; w2 < 8; ++w2) sm += red[(w2 * 16 + p) * 64 + lane];
        const bf16_t v = (bf16_t)f2bf(sm * proj_scale(n));
        for (int b = 0; b < BATCH; ++b) WSP(bf16_t, WS_PROJ)[((size_t)b * TP + 48 + p) * PC + n] = v; }
    __syncthreads();
}
__device__ __forceinline__ void phase_prologue(Ctx& C) {
    for (int cb = C.bid; cb < PC / 64; cb += C.G) meta_proj_block(C, cb);
    LAS float* scr = (LAS float*)(C.lds + C.wave * 16384);
    const int gw = C.bid * NWAVES + C.wave, NGW = C.G * NWAVES;
    constexpr int I_IN = (DM / 64) * (PC / 32), I_OUT = (DM / 64) * (DM / 32), I_UP = (DM / 64) * (NUP / 32), I_DN = (DFF / 64) * (DM / 32);
#if USE_FP8
    { constexpr int I_IN8 = (DM / 64) * (C_SPLIT / 32), I_INB = (DM / 64) * ((PC - C_SPLIT) / 32);
    for (int it = gw; it < I_IN8 + I_INB + I_OUT + I_UP + I_DN; it += NGW) {
        int r = it;
        if (r < I_IN8) { transpose_item_f8<1>(IN_(4), DM, C_END, C_SPLIT, (unsigned char*)WSP(unsigned char, WS_WIN8), scr, r, C.lane, 64.f); continue; } r -= I_IN8;
        if (r < I_INB) { const int nblk = (PC - C_SPLIT) / 32, kb = r / nblk, nb = r % nblk; transpose_item<1>(IN_(4), DM, C_END, PC, WSP(bf16_t, WS_WINB) - (size_t)C_SPLIT * DM, scr, kb * (PC / 32) + C_SPLIT / 32 + nb, C.lane); continue; } r -= I_INB;
        if (r < I_OUT) { transpose_item_f8<0>(IN_(9), DM, DM, DM, WSP(unsigned char, WS_WOUT8), scr, r, C.lane, 64.f); continue; } r -= I_OUT;
        if (r < I_UP) { transpose_item_f8<2>(IN_(12), DM, NUP, NUP, WSP(unsigned char, WS_WUP8), scr, r, C.lane, 64.f); continue; } r -= I_UP;
        transpose_item_f8<0>(IN_(15), DFF, DM, DM, WSP(unsigned char, WS_WDN8), scr, r, C.lane, 64.f);
    } }
#else
    for (int it = gw; it < I_IN + I_OUT + I_UP + I_DN; it += NGW) {
        int r = it;
        if (r < I_IN) { transpose_item<1>(IN_(4), DM, C_END, PC, WSP(bf16_t, WS_WIN), scr, r, C.lane); continue; } r -= I_IN;
        if (r < I_OUT) { transpose_item<4>(IN_(9), DM, DM, DM, WSP(bf16_t, WS_WOUT), scr, r, C.lane); continue; } r -= I_OUT;
        if (r < I_UP) { transpose_item<2>(IN_(12), DM, NUP, NUP, WSP(bf16_t, WS_WUP), scr, r, C.lane); continue; } r -= I_UP;
        transpose_item<3>(IN_(15), DFF, DM, DM, WSP(bf16_t, WS_WDN), scr, r, C.lane);
    }
#endif
    for (int m = 4 * gw; m < MR; m += 4 * NGW) ln_row4(IN_(0) + (size_t)m * DM, IN_(2), IN_(3), WSP(bf16_t, WS_H0) + (size_t)m * DM, C.lane, USE_FP8 ? (bf16_t*)(WSP(unsigned char, WS_H0Q) + (size_t)m * DM) : WSP(bf16_t, WS_H0Q) + (size_t)m * DM);
    const int gt = C.bid * NTHR + C.tid, NGT = C.G * NTHR;
    for (int it = gt; it < BATCH * 48 * (PC / 8); it += NGT) {
        const int b = it / (48 * (PC / 8)), r = it % (48 * (PC / 8)), row = r / (PC / 8), c8 = r % (PC / 8);
        *(u32x4*)(WSP(bf16_t, WS_PROJ) + ((size_t)b * TP + row) * PC + c8 * 8) = (u32x4){0u, 0u, 0u, 0u};
    }
    for (int it = gt; it < BATCH * TP * NTILE; it += NGT) {
        const int t = it % NTILE, bi = it / NTILE, i = bi % TP, c = i >> 6;
        if (i < 256) { u64 w = 0ull; if (i >= 48) { if (t == 0) w = 0xFFFF000000000000ull; else if (t <= c) w = ~0ull; } WSP(u64, WS_MASK)[it] = w; }
        else if (t > c) WSP(u64, WS_MASK)[it] = 0ull;
    }
}
__device__ __forceinline__ float proj_scale(int n) { return n < 512 ? QSCALE : ((n >= C_BQ && n < C_BK) ? 0.125f : 1.f); }
__device__ __forceinline__ void phase_meta(Ctx& C) {
    const int gw = C.bid * NWAVES + C.wave, NGW = C.G * NWAVES;
    for (int n = gw; n < PC; n += NGW) {
        const int sc = src_col_in(n);
        float acc[16];
#pragma unroll
        for (int p = 0; p < 16; ++p) acc[p] = 0.f;
        if (sc >= 0) {
            for (int k = C.lane; k < DM; k += 64) { const float w = IN_(4)[(size_t)k * C_END + sc];
#pragma unroll
                for (int p = 0; p < 16; ++p) acc[p] += WSP(float, WS_H0M)[p * DM + k] * w; }
        }
        float mine = 0.f;
#pragma unroll
        for (int p = 0; p < 16; ++p) { const float t = wave_sum(acc[p]); if (C.lane == p) mine = t; }
        if (C.lane < 16) { const bf16_t v = (bf16_t)f2bf(mine * proj_scale(n));
            for (int b = 0; b < BATCH; ++b) WSP(bf16_t, WS_PROJ)[((size_t)b * TP + 48 + C.lane) * PC + n] = v; }
    }
#if PROBE_F32IDX
    for (int n = gw; n < 324; n += NGW) {
        const int sc = n < 256 ? 1536 + n : (n < 320 ? 1792 + (n - 256) : 1856 + (n - 320));
        float acc[16];
#pragma unroll
        for (int p = 0; p < 16; ++p) acc[p] = 0.f;
        for (int k = C.lane; k < DM; k += 64) { const float w = IN_(4)[(size_t)k * C_END + sc];
#pragma unroll
            for (int p = 0; p < 16; ++p) acc[p] += WSP(float, WS_H0M)[p * DM + k] * w; }
        float mine = 0.f;
#pragma unroll
        for (int p = 0; p < 16; ++p) { const float t = wave_sum(acc[p]); if (C.lane == p) mine = t; }
        if (C.lane < 16) for (int b = 0; b < BATCH; ++b) WSP(float, WS_IDX)[((size_t)b * TP + 48 + C.lane) * 384 + n] = mine;
    }
#endif
    const int gt = C.bid * NTHR + C.tid, NGT = C.G * NTHR;
    for (int it = gt; it < BATCH * 48 * (PC / 8); it += NGT) {
        const int b = it / (48 * (PC / 8)), r = it % (48 * (PC / 8)), row = r / (PC / 8), c8 = r % (PC / 8);
        *(u32x4*)(WSP(bf16_t, WS_PROJ) + ((size_t)b * TP + row) * PC + c8 * 8) = (u32x4){0u, 0u, 0u, 0u};
    }
    for (int it = gt; it < BATCH * TP * NTILE; it += NGT) {
        const int t = it % NTILE, bi = it / NTILE, i = bi % TP, c = i >> 6;
        if (i < 256) { u64 w = 0ull; if (i >= 48) { if (t == 0) w = 0xFFFF000000000000ull; else if (t <= c) w = ~0ull; } WSP(u64, WS_MASK)[it] = w; }
        else if (t > c) WSP(u64, WS_MASK)[it] = 0ull;
    }
}

template <class Epi> __device__ __forceinline__ void naive_gemm(Ctx& C, const bf16_t* A, const bf16_t* Bt, int M, int N, int K, const Epi& epi) {
    LAS float* As = (LAS float*)C.lds; LAS float* Bs = As + 32 * 132;
    const int tn = N >> 7, ntile = (M >> 7) * tn, tid = C.tid;
    const int ty = tid >> 4, tx = tid & 15, lr = tid >> 2, lk = (tid & 3) * 8;
    for (int tile = C.bid; tile < ntile; tile += C.G) {
        const int m0 = (tile / tn) << 7, n0 = (tile % tn) << 7;
        float acc[4][8];
#pragma unroll
        for (int i = 0; i < 4; ++i)
#pragma unroll
            for (int j = 0; j < 8; ++j) acc[i][j] = 0.f;
        for (int k0 = 0; k0 < K; k0 += 32) {
            const u32x4 av = *(const u32x4*)(A + (size_t)(m0 + lr) * K + k0 + lk);
            const u32x4 bv = *(const u32x4*)(Bt + (size_t)(n0 + lr) * K + k0 + lk);
            __syncthreads();
            As[(lk + 0) * 132 + lr] = bflo(av.x); As[(lk + 1) * 132 + lr] = bfhi(av.x); As[(lk + 2) * 132 + lr] = bflo(av.y); As[(lk + 3) * 132 + lr] = bfhi(av.y);
            As[(lk + 4) * 132 + lr] = bflo(av.z); As[(lk + 5) * 132 + lr] = bfhi(av.z); As[(lk + 6) * 132 + lr] = bflo(av.w); As[(lk + 7) * 132 + lr] = bfhi(av.w);
            Bs[(lk + 0) * 132 + lr] = bflo(bv.x); Bs[(lk + 1) * 132 + lr] = bfhi(bv.x); Bs[(lk + 2) * 132 + lr] = bflo(bv.y); Bs[(lk + 3) * 132 + lr] = bfhi(bv.y);
            Bs[(lk + 4) * 132 + lr] = bflo(bv.z); Bs[(lk + 5) * 132 + lr] = bfhi(bv.z); Bs[(lk + 6) * 132 + lr] = bflo(bv.w); Bs[(lk + 7) * 132 + lr] = bfhi(bv.w);
            __syncthreads();
#pragma unroll 8
            for (int k = 0; k < 32; ++k) {
                const f32x4 a = *(const LAS f32x4*)(As + k * 132 + ty * 4);
                const f32x4 b0 = *(const LAS f32x4*)(Bs + k * 132 + tx * 8), b1 = *(const LAS f32x4*)(Bs + k * 132 + tx * 8 + 4);
#pragma unroll
                for (int i = 0; i < 4; ++i) { acc[i][0] += a[i] * b0[0]; acc[i][1] += a[i] * b0[1]; acc[i][2] += a[i] * b0[2]; acc[i][3] += a[i] * b0[3];
                                              acc[i][4] += a[i] * b1[0]; acc[i][5] += a[i] * b1[1]; acc[i][6] += a[i] * b1[2]; acc[i][7] += a[i] * b1[3]; }
            }
        }
#pragma unroll
        for (int i = 0; i < 4; ++i) epi(m0 + ty * 4 + i, n0 + tx * 8, acc[i]);
    }
    __syncthreads();
}
__device__ __forceinline__ void naive_idx_gemm(Ctx& C) {
    LAS float* As = (LAS float*)C.lds; LAS float* Bs = As + 32 * 132;
    const int tid = C.tid, ty = tid >> 4, tx = tid & 15, lr = tid >> 2, lk = (tid & 3) * 8, bk = tid >> 4, bn = (tid & 15) * 8;
    const float* X = IN_(0); const float* W = IN_(4); const float* G_ = IN_(2); const float* Bb = IN_(3);
    for (int tile = C.bid; tile < 256 * 3; tile += C.G) {
        const int m0 = (tile / 3) << 7, n0 = (tile % 3) << 7;
        float acc[4][8];
#pragma unroll
        for (int i = 0; i < 4; ++i)
#pragma unroll
            for (int j = 0; j < 8; ++j) acc[i][j] = 0.f;
        const float mean = WSP(float, WS_STAT)[2 * (m0 + lr)], rstd = WSP(float, WS_STAT)[2 * (m0 + lr) + 1];
        for (int k0 = 0; k0 < DM; k0 += 32) {
            const f32x4 x0 = *(const f32x4*)(X + (size_t)(m0 + lr) * DM + k0 + lk), x1 = *(const f32x4*)(X + (size_t)(m0 + lr) * DM + k0 + lk + 4);
            const f32x4 g0 = *(const f32x4*)(G_ + k0 + lk), g1 = *(const f32x4*)(G_ + k0 + lk + 4), b0 = *(const f32x4*)(Bb + k0 + lk), b1 = *(const f32x4*)(Bb + k0 + lk + 4);
            float bw[8];
#pragma unroll
            for (int j = 0; j < 8; ++j) { const int n = n0 + bn + j; const int sc = n < 256 ? 1536 + n : (n < 320 ? 1792 + (n - 256) : (n < 324 ? 1856 + (n - 320) : -1)); bw[j] = sc >= 0 ? W[(size_t)(k0 + bk) * C_END + sc] : 0.f; }
            __syncthreads();
            const f32x4 a0 = (x0 - mean) * rstd * g0 + b0, a1 = (x1 - mean) * rstd * g1 + b1;
            As[(lk + 0) * 132 + lr] = a0[0]; As[(lk + 1) * 132 + lr] = a0[1]; As[(lk + 2) * 132 + lr] = a0[2]; As[(lk + 3) * 132 + lr] = a0[3];
            As[(lk + 4) * 132 + lr] = a1[0]; As[(lk + 5) * 132 + lr] = a1[1]; As[(lk + 6) * 132 + lr] = a1[2]; As[(lk + 7) * 132 + lr] = a1[3];
#pragma unroll
            for (int j = 0; j < 8; ++j) Bs[bk * 132 + bn + j] = bw[j];
            __syncthreads();
#pragma unroll 8
            for (int k = 0; k < 32; ++k) {
                const f32x4 a = *(const LAS f32x4*)(As + k * 132 + ty * 4);
                const f32x4 c0 = *(const LAS f32x4*)(Bs + k * 132 + tx * 8), c1 = *(const LAS f32x4*)(Bs + k * 132 + tx * 8 + 4);
#pragma unroll
                for (int i = 0; i < 4; ++i) { acc[i][0] += a[i] * c0[0]; acc[i][1] += a[i] * c0[1]; acc[i][2] += a[i] * c0[2]; acc[i][3] += a[i] * c0[3];
                                              acc[i][4] += a[i] * c1[0]; acc[i][5] += a[i] * c1[1]; acc[i][6] += a[i] * c1[2]; acc[i][7] += a[i] * c1[3]; }
            }
        }
#pragma unroll
        for (int i = 0; i < 4; ++i) { const int m = m0 + ty * 4 + i, b = m >> 11, s_ = m & 2047; float* o = WSP(float, WS_IDX) + ((size_t)b * TP + 64 + s_) * 384 + n0 + tx * 8;
            ((f32x4*)o)[0] = (f32x4){acc[i][0], acc[i][1], acc[i][2], acc[i][3]}; ((f32x4*)o)[1] = (f32x4){acc[i][4], acc[i][5], acc[i][6], acc[i][7]}; }
    }
    __syncthreads();
}
__device__ __forceinline__ void store8_mix(bf16_t* p, const float (&v)[8]);
__device__ __forceinline__ void store8_bf16(bf16_t* p, const float (&v)[8]) { u32x4 o; o.x = pk2(v[0], v[1]); o.y = pk2(v[2], v[3]); o.z = pk2(v[4], v[5]); o.w = pk2(v[6], v[7]); *(u32x4*)p = o; }
__device__ __forceinline__ void store8_f8(unsigned char* p, const float (&v)[8], float sc) { typedef unsigned u32x2 __attribute__((ext_vector_type(2))); *(u32x2*)p = (u32x2){pk4_f8(v[0], v[1], v[2], v[3], sc), pk4_f8(v[4], v[5], v[6], v[7], sc)}; }
__device__ __forceinline__ void store8_mix(bf16_t* p, const float (&v)[8]) { if (EMU_FP8_OUT) { float w[8]; for (int j = 0; j < 8; ++j) w[j] = q8(v[j], S_MIX); store8_bf16(p, w); } else store8_bf16(p, v); }
struct EpiProj { bf16_t* proj; int coff;
    __device__ __forceinline__ void operator()(int m, int n_, const float (&v)[8]) const {
        const int n = n_ + coff; const int b = m >> 11, s = m & 2047; const float sc = proj_scale(n); float w[8];
#pragma unroll
        for (int j = 0; j < 8; ++j) w[j] = v[j] * sc;
        store8_bf16(proj + ((size_t)b * TP + 64 + s) * PC + n, w); } };
struct EpiY { float* y; const bf16_t* res;
    __device__ __forceinline__ void operator()(int m, int n, const float (&v)[8]) const {
        const u32x4 r = *(const u32x4*)(res + (size_t)m * DM + n); float* o = y + (size_t)m * DM + n;
        ((f32x4*)o)[0] = (f32x4){ALPHA * bflo(r.x) + v[0], ALPHA * bfhi(r.x) + v[1], ALPHA * bflo(r.y) + v[2], ALPHA * bfhi(r.y) + v[3]};
        ((f32x4*)o)[1] = (f32x4){ALPHA * bflo(r.z) + v[4], ALPHA * bfhi(r.z) + v[5], ALPHA * bflo(r.w) + v[6], ALPHA * bfhi(r.w) + v[7]}; } };
struct EpiU { bf16_t* u;
    __device__ __forceinline__ void operator()(int m, int n, const float (&v)[8]) const { store8_bf16(u + (size_t)m * DFF + n, v); } };

namespace pg8 {
#define PG8_LAS __attribute__((address_space(3)))
typedef unsigned short bf16_t;
typedef short bf16x8 __attribute__((ext_vector_type(8)));
typedef float f32x4 __attribute__((ext_vector_type(4)));
typedef unsigned u32x4 __attribute__((ext_vector_type(4)));
constexpr int BM = 256, BK = 64, HALF = 128, HTB = HALF * BK * 2  , STAGE_BYTES = 8 * HTB, NXCD = 8, WGM = 8;

__host__ __device__ __forceinline__ int lds_byte(int r, int c) { const int st = (r >> 4) * 2 + (c >> 5), rr = r & 15, cc = c & 31, ob = rr * 64 + cc * 2; return st * 1024 + (ob ^ (((ob >> 9) & 1) << 5)); }
__host__ __device__ __forceinline__ void stage_rc(int b, int& R, int& C) { const int st = b / 1024, sb = b % 1024, swz = sb ^ (((sb >> 9) & 1) << 5); R = (st >> 1) * 16 + swz / 64; C = (st & 1) * 32 + (swz % 64) / 2; }
__host__ __device__ __forceinline__ int perm32(int rho) { const int n = rho >> 4, i = rho & 15; return 8 * (i >> 2) + 4 * n + (i & 3); }

struct Unit { int pm, pn; };
struct Gemm { const bf16_t* A; const bf16_t* Bt; int M, N, K; };

struct StaticOrder {
    int nM, nN, nwg, G, c;
    __host__ __device__ __forceinline__ void init(int M, int N, int G_, int c_) { nM = M / BM; nN = N / BM; nwg = nM * nN; G = G_; c = c_; }
    __host__ __device__ __forceinline__ bool next(int i, Unit& u) const {
        const long L = (long)i * G + c; if (L >= nwg) return false;
        int wgid = (int)L; { const int q = nwg / NXCD, r = nwg % NXCD, xcd = wgid % NXCD, off = wgid / NXCD; wgid = (xcd < r ? xcd * (q + 1) : r * (q + 1) + (xcd - r) * q) + off; }
        const int nig = WGM * nN, gid = wgid / nig, fm = gid * WGM, gsz = (nM - fm) < WGM ? (nM - fm) : WGM;
        u.pm = fm + ((wgid % nig) % gsz); u.pn = (wgid % nig) / gsz; return true;
    }
    __device__ __forceinline__ void a_ready(const Unit&) const {}
    __device__ __forceinline__ void done(const Unit&) const {}
};

__device__ __forceinline__ unsigned cvt_pk_bf16(float lo, float hi) { unsigned r; asm volatile("v_cvt_pk_bf16_f32 %0, %1, %2" : "=v"(r) : "v"(lo), "v"(hi)); return r; }
typedef int v8i_t __attribute__((ext_vector_type(8))); typedef int v4i_t __attribute__((ext_vector_type(4)));
__device__ __forceinline__ v8i_t cat8(bf16x8 a, bf16x8 b) { const v4i_t x = __builtin_bit_cast(v4i_t, a), y = __builtin_bit_cast(v4i_t, b); return __builtin_shufflevector(x, y, 0, 1, 2, 3, 4, 5, 6, 7); }
template <class Epi, class Sched, bool ALIGN_EPI = false, bool SP2 = false, bool F8 = false, int SCW = 127, int SCA = 127>
__device__ __forceinline__ void gemm_phase(PG8_LAS unsigned char* lds, const Gemm g, const Sched& S, const Epi& E) {
    const int tid = threadIdx.x, wid = __builtin_amdgcn_readfirstlane(tid >> 6), lane = tid & 63, wr = wid >> 2, wc = wid & 3, fr = lane & 15, fq = lane >> 4;
    const int K = g.K, nt = K / BK;
    unsigned voffA[2], voffB[2];
#pragma unroll
    for (int i = 0; i < 2; ++i) { int R, C; stage_rc(tid * 16 + i * 8192, R, C); const int Rb = Epi::PERM ? ((R & ~31) + perm32(R & 31)) : R;
        voffA[i] = (unsigned)(R * K + C) * 2u; voffB[i] = (unsigned)(Rb * K + C) * 2u; }
    const size_t kstep = (size_t)(BK * 2);
    const size_t hstep = (size_t)HALF * K * 2;
    const size_t tstep = 2 * hstep;
    const unsigned ldsw = (unsigned)wid * 1024u;
    const int aoff = lds_byte(wr * 64 + fr, fq * 8), boff = lds_byte(wc * 32 + fr, fq * 8);
#define PG8_SA(b, h) (((b) * 2 + (h)) * HTB)
#define PG8_SB(b, h) ((4 + (b) * 2 + (h)) * HTB)
#define PG8_STAGE(bufoff, gbase, voff) do { _Pragma("unroll") for (int _i = 0; _i < 2; ++_i) \
        __builtin_amdgcn_global_load_lds((const unsigned*)((const char*)(gbase) + (voff)[_i]), (PG8_LAS unsigned*)(lds + (bufoff) + ldsw + _i * 8192), 16, 0, 0); } while (0)
#define PG8_LDA(dst, b, h) do { _Pragma("unroll") for (int m = 0; m < 4; ++m) _Pragma("unroll") for (int k = 0; k < 2; ++k) dst[m][k] = *(const PG8_LAS bf16x8*)(lds + PG8_SA(b, h) + aoff + m * 2048 + k * 1024); } while (0)
#define PG8_LDB(dst, b, h) do { _Pragma("unroll") for (int n = 0; n < 2; ++n) _Pragma("unroll") for (int k = 0; k < 2; ++k) dst[n][k] = *(const PG8_LAS bf16x8*)(lds + PG8_SB(b, h) + boff + n * 2048 + k * 1024); } while (0)
#define PG8_LDA8(dst, b, h) do { _Pragma("unroll") for (int m = 0; m < 4; ++m) { const v4i_t lo_ = *(const PG8_LAS v4i_t*)(lds + PG8_SA(b, h) + aoff + m * 2048), hi_ = *(const PG8_LAS v4i_t*)(lds + PG8_SA(b, h) + aoff + m * 2048 + 1024); dst[m] = __builtin_shufflevector(lo_, hi_, 0, 1, 2, 3, 4, 5, 6, 7); } } while (0)
#define PG8_LDB8(dst, b, h) do { _Pragma("unroll") for (int n = 0; n < 2; ++n) { const v4i_t lo_ = *(const PG8_LAS v4i_t*)(lds + PG8_SB(b, h) + boff + n * 2048), hi_ = *(const PG8_LAS v4i_t*)(lds + PG8_SB(b, h) + boff + n * 2048 + 1024); dst[n] = __builtin_shufflevector(lo_, hi_, 0, 1, 2, 3, 4, 5, 6, 7); } } while (0)
#define PG8_MMA8(ai, bj, A8, B8) do { __builtin_amdgcn_s_setprio(1); _Pragma("unroll") for (int m = 0; m < 4; ++m) _Pragma("unroll") for (int n = 0; n < 2; ++n) \
        asm volatile("v_mfma_scale_f32_16x16x128_f8f6f4 %0, %1, %2, %0, %3, %4 op_sel_hi:[0,0,0]" : "+v"(acc[ai][bj][m][n]) : "v"(B8[n]), "v"(A8[m]), "v"(scw_r), "v"(sca_r)); __builtin_amdgcn_s_setprio(0); } while (0)
#define PG8_MMA(ai, bj, At, Bt) do { __builtin_amdgcn_s_setprio(1); _Pragma("unroll") for (int m = 0; m < 4; ++m) _Pragma("unroll") for (int n = 0; n < 2; ++n) _Pragma("unroll") for (int k = 0; k < 2; ++k) \
        acc[ai][bj][m][n] = __builtin_amdgcn_mfma_f32_16x16x32_bf16(Bt[n][k], At[m][k], acc[ai][bj][m][n], 0, 0, 0); __builtin_amdgcn_s_setprio(0); } while (0)
#define PG8_WAIT_V(n) asm volatile("s_waitcnt vmcnt(" #n ")" ::: "memory")
#define PG8_WAIT_L(n) asm volatile("s_waitcnt lgkmcnt(" #n ")" ::: "memory")
#define PG8_BAR __builtin_amdgcn_s_barrier()
#define PG8_SCHED __builtin_amdgcn_sched_barrier(0)
    Unit cur, nxt; int ui = 0;
    if (!S.next(0, cur)) return;
    f32x4 acc[2][2][4][2];
#pragma unroll
    for (int a = 0; a < 2; ++a)
#pragma unroll
        for (int b = 0; b < 2; ++b)
#pragma unroll
            for (int m = 0; m < 4; ++m)
#pragma unroll
                for (int n = 0; n < 2; ++n) acc[a][b][m][n] = (f32x4){0.f, 0.f, 0.f, 0.f};
    bf16x8 At[4][2], B0[2][2], B1[2][2];
    v8i_t A8[4], B08[2], B18[2];
    int scw_r = SCW * 0x01010101, sca_r = SCA * 0x01010101; asm volatile("" : "+v"(scw_r), "+v"(sca_r));
    const char* cA = (const char*)g.A + (size_t)cur.pm * tstep; const char* cB = (const char*)g.Bt + (size_t)cur.pn * tstep;
    S.a_ready(cur);
    if constexpr (SP2) {
        PG8_STAGE(PG8_SB(0, 0), cB, voffB); PG8_STAGE(PG8_SB(0, 1), cB + hstep, voffB); PG8_STAGE(PG8_SA(0, 0), cA, voffA); PG8_STAGE(PG8_SA(0, 1), cA + hstep, voffA);
        if (wr == 1) PG8_BAR;
        PG8_WAIT_V(2); PG8_BAR;
        PG8_STAGE(PG8_SB(1, 0), cB + kstep, voffB); PG8_STAGE(PG8_SA(1, 0), cA + kstep, voffA); PG8_STAGE(PG8_SB(1, 1), cB + hstep + kstep, voffB);
        PG8_WAIT_V(6); PG8_BAR;
    } else {
        PG8_STAGE(PG8_SB(0, 0), cB, voffB); PG8_STAGE(PG8_SA(0, 0), cA, voffA); PG8_STAGE(PG8_SB(0, 1), cB + hstep, voffB); PG8_STAGE(PG8_SA(0, 1), cA + hstep, voffA);
        if (wr == 1) PG8_BAR;
        PG8_WAIT_V(4); PG8_BAR;
        PG8_STAGE(PG8_SB(1, 0), cB + kstep, voffB); PG8_STAGE(PG8_SA(1, 0), cA + kstep, voffA); PG8_STAGE(PG8_SB(1, 1), cB + hstep + kstep, voffB);
        PG8_WAIT_V(6); PG8_BAR;
    }
    for (;;) {
        const bool has_next = S.next(ui + 1, nxt);
        const char* nA = has_next ? (const char*)g.A + (size_t)nxt.pm * tstep : cA; const char* nB = has_next ? (const char*)g.Bt + (size_t)nxt.pn * tstep : cB;
#pragma unroll 1
        for (int t = 0; t < nt; t += 2) {
            const bool last = (t == nt - 2);
            const char* a1 = cA + (size_t)(t + 1) * kstep;
            const char* a2 = last ? nA : cA + (size_t)(t + 2) * kstep; const char* b2 = last ? nB : cB + (size_t)(t + 2) * kstep;
            const char* a3 = a2 + kstep; const char* b3 = b2 + kstep;
            if (last && has_next) S.a_ready(nxt);
            if constexpr (SP2 && F8) {
            PG8_LDB8(B08, 0, 0); PG8_LDB8(B18, 0, 1); PG8_SCHED; PG8_LDA8(A8, 0, 0); PG8_STAGE(PG8_SA(1, 1), a1 + hstep, voffA);
            PG8_WAIT_V(8); PG8_WAIT_L(0); PG8_BAR; PG8_MMA8(0, 0, A8, B08); PG8_MMA8(0, 1, A8, B18); PG8_BAR; PG8_SCHED;
            PG8_LDA8(A8, 0, 1); PG8_STAGE(PG8_SB(0, 0), b2, voffB); PG8_STAGE(PG8_SB(0, 1), b2 + hstep, voffB); PG8_STAGE(PG8_SA(0, 0), a2, voffA);
            PG8_WAIT_V(8); PG8_WAIT_L(0); PG8_BAR; PG8_MMA8(1, 0, A8, B08); PG8_MMA8(1, 1, A8, B18); PG8_BAR; PG8_SCHED;
            PG8_LDB8(B08, 1, 0); PG8_LDB8(B18, 1, 1); PG8_SCHED; PG8_LDA8(A8, 1, 0); PG8_STAGE(PG8_SA(0, 1), a2 + hstep, voffA);
            PG8_WAIT_V(8); PG8_WAIT_L(0); PG8_BAR; PG8_MMA8(0, 0, A8, B08); PG8_MMA8(0, 1, A8, B18); PG8_BAR; PG8_SCHED;
            PG8_LDA8(A8, 1, 1); PG8_STAGE(PG8_SB(1, 0), b3, voffB); PG8_STAGE(PG8_SB(1, 1), b3 + hstep, voffB); PG8_STAGE(PG8_SA(1, 0), a3, voffA);
            PG8_WAIT_V(8); PG8_WAIT_L(0); PG8_BAR; PG8_MMA8(1, 0, A8, B08); PG8_MMA8(1, 1, A8, B18); PG8_BAR; PG8_SCHED;
            } else if constexpr (SP2) {
            PG8_LDB(B0, 0, 0); PG8_LDB(B1, 0, 1); PG8_SCHED; PG8_LDA(At, 0, 0); PG8_STAGE(PG8_SA(1, 1), a1 + hstep, voffA);
            PG8_WAIT_V(8); PG8_WAIT_L(0); PG8_BAR; PG8_MMA(0, 0, At, B0); PG8_MMA(0, 1, At, B1); PG8_BAR; PG8_SCHED;
            PG8_LDA(At, 0, 1); PG8_STAGE(PG8_SB(0, 0), b2, voffB); PG8_STAGE(PG8_SB(0, 1), b2 + hstep, voffB); PG8_STAGE(PG8_SA(0, 0), a2, voffA);
            PG8_WAIT_V(8); PG8_WAIT_L(0); PG8_BAR; PG8_MMA(1, 0, At, B0); PG8_MMA(1, 1, At, B1); PG8_BAR; PG8_SCHED;
            PG8_LDB(B0, 1, 0); PG8_LDB(B1, 1, 1); PG8_SCHED; PG8_LDA(At, 1, 0); PG8_STAGE(PG8_SA(0, 1), a2 + hstep, voffA);
            PG8_WAIT_V(8); PG8_WAIT_L(0); PG8_BAR; PG8_MMA(0, 0, At, B0); PG8_MMA(0, 1, At, B1); PG8_BAR; PG8_SCHED;
            PG8_LDA(At, 1, 1); PG8_STAGE(PG8_SB(1, 0), b3, voffB); PG8_STAGE(PG8_SB(1, 1), b3 + hstep, voffB); PG8_STAGE(PG8_SA(1, 0), a3, voffA);
            PG8_WAIT_V(8); PG8_WAIT_L(0); PG8_BAR; PG8_MMA(1, 0, At, B0); PG8_MMA(1, 1, At, B1); PG8_BAR; PG8_SCHED;
            } else if constexpr (F8) {
            PG8_LDB8(B08, 0, 0); PG8_SCHED; PG8_LDA8(A8, 0, 0); PG8_STAGE(PG8_SA(1, 1), a1 + hstep, voffA);
            PG8_WAIT_L(8); PG8_BAR; PG8_WAIT_L(0); PG8_MMA8(0, 0, A8, B08); PG8_BAR; PG8_SCHED;
            PG8_LDB8(B18, 0, 1); PG8_STAGE(PG8_SB(0, 0), b2, voffB);
            PG8_BAR; PG8_WAIT_L(0); PG8_MMA8(0, 1, A8, B18); PG8_BAR;
            PG8_LDA8(A8, 0, 1); PG8_STAGE(PG8_SA(0, 0), a2, voffA);
            PG8_BAR; PG8_WAIT_L(0); PG8_MMA8(1, 0, A8, B08); PG8_BAR; PG8_SCHED;
            PG8_STAGE(PG8_SB(0, 1), b2 + hstep, voffB);
            PG8_WAIT_V(6); PG8_BAR; PG8_MMA8(1, 1, A8, B18); PG8_BAR;
            PG8_LDB8(B08, 1, 0); PG8_SCHED; PG8_LDA8(A8, 1, 0); PG8_STAGE(PG8_SA(0, 1), a2 + hstep, voffA);
            PG8_WAIT_L(8); PG8_BAR; PG8_WAIT_L(0); PG8_MMA8(0, 0, A8, B08); PG8_BAR; PG8_SCHED;
            PG8_LDB8(B18, 1, 1); PG8_STAGE(PG8_SB(1, 0), b3, voffB);
            PG8_BAR; PG8_WAIT_L(0); PG8_MMA8(0, 1, A8, B18); PG8_BAR;
            PG8_LDA8(A8, 1, 1); PG8_STAGE(PG8_SA(1, 0), a3, voffA);
            PG8_BAR; PG8_WAIT_L(0); PG8_MMA8(1, 0, A8, B08); PG8_BAR; PG8_SCHED;
            PG8_STAGE(PG8_SB(1, 1), b3 + hstep, voffB);
            PG8_WAIT_V(6); PG8_BAR; PG8_MMA8(1, 1, A8, B18); PG8_BAR;
            } else {
            PG8_LDB(B0, 0, 0); PG8_SCHED; PG8_LDA(At, 0, 0); PG8_STAGE(PG8_SA(1, 1), a1 + hstep, voffA);
            PG8_WAIT_L(8); PG8_BAR; PG8_WAIT_L(0); PG8_MMA(0, 0, At, B0); PG8_BAR; PG8_SCHED;
            PG8_LDB(B1, 0, 1); PG8_STAGE(PG8_SB(0, 0), b2, voffB);
            PG8_BAR; PG8_WAIT_L(0); PG8_MMA(0, 1, At, B1); PG8_BAR;
            PG8_LDA(At, 0, 1); PG8_STAGE(PG8_SA(0, 0), a2, voffA);
            PG8_BAR; PG8_WAIT_L(0); PG8_MMA(1, 0, At, B0); PG8_BAR; PG8_SCHED;
            PG8_STAGE(PG8_SB(0, 1), b2 + hstep, voffB);
            PG8_WAIT_V(6); PG8_BAR; PG8_MMA(1, 1, At, B1); PG8_BAR;
            PG8_LDB(B0, 1, 0); PG8_SCHED; PG8_LDA(At, 1, 0); PG8_STAGE(PG8_SA(0, 1), a2 + hstep, voffA);
            PG8_WAIT_L(8); PG8_BAR; PG8_WAIT_L(0); PG8_MMA(0, 0, At, B0); PG8_BAR; PG8_SCHED;
            PG8_LDB(B1, 1, 1); PG8_STAGE(PG8_SB(1, 0), b3, voffB);
            PG8_BAR; PG8_WAIT_L(0); PG8_MMA(0, 1, At, B1); PG8_BAR;
            PG8_LDA(At, 1, 1); PG8_STAGE(PG8_SA(1, 0), a3, voffA);
            PG8_BAR; PG8_WAIT_L(0); PG8_MMA(1, 0, At, B0); PG8_BAR; PG8_SCHED;
            PG8_STAGE(PG8_SB(1, 1), b3 + hstep, voffB);
            PG8_WAIT_V(6); PG8_BAR; PG8_MMA(1, 1, At, B1); PG8_BAR;
            }
        }
        if constexpr (F8) asm volatile("s_nop 15\n\ts_nop 15" ::: "memory");
        if constexpr (ALIGN_EPI) { if (wr == 0) PG8_BAR; }
        if constexpr (!Epi::AFTER_DRAIN) { E(acc, cur, wr, wc, fr, fq); S.done(cur); }
        if (!has_next) break;
#pragma unroll
        for (int a = 0; a < 2; ++a)
#pragma unroll
            for (int b = 0; b < 2; ++b)
#pragma unroll
                for (int m = 0; m < 4; ++m)
#pragma unroll
                    for (int n = 0; n < 2; ++n) acc[a][b][m][n] = (f32x4){0.f, 0.f, 0.f, 0.f};
        cur = nxt; cA = nA; cB = nB; ++ui;
        if constexpr (ALIGN_EPI) { if (wr == 1) PG8_BAR; }
    }
    PG8_WAIT_V(0);
    if constexpr (!ALIGN_EPI) { if (wr == 0) PG8_BAR; }
    PG8_BAR;
    if constexpr (Epi::AFTER_DRAIN) { E.fused(acc, cur, wr, wc, fr, fq, lds, wid, lane); S.done(cur); }
#undef PG8_SA
#undef PG8_SB
#undef PG8_STAGE
#undef PG8_LDA
#undef PG8_LDA8
#undef PG8_LDB8
#undef PG8_MMA8
#undef PG8_LDB
#undef PG8_MMA
#undef PG8_WAIT_V
#undef PG8_WAIT_L
#undef PG8_BAR
#undef PG8_SCHED
}
}

template <class E> struct EpiAdapt {
    static constexpr bool PERM = true, AFTER_DRAIN = false;
    E e;
    __device__ __forceinline__ void operator()(const pg8::f32x4 (&acc)[2][2][4][2], const pg8::Unit& u, int wr, int wc, int fr, int fq) const {
#pragma unroll
        for (int ai = 0; ai < 2; ++ai)
#pragma unroll
            for (int m = 0; m < 4; ++m) { const int row = u.pm * 256 + ai * 128 + wr * 64 + m * 16 + fr;
#pragma unroll
                for (int bj = 0; bj < 2; ++bj) { const int col = u.pn * 256 + bj * 128 + wc * 32 + 8 * fq;
                    const float v[8] = {acc[ai][bj][m][0][0], acc[ai][bj][m][0][1], acc[ai][bj][m][0][2], acc[ai][bj][m][0][3], acc[ai][bj][m][1][0], acc[ai][bj][m][1][1], acc[ai][bj][m][1][2], acc[ai][bj][m][1][3]};
                    e(row, col, v); } }
    }
};
template <class E> __device__ __forceinline__ void fast_gemm(Ctx& C, const bf16_t* A, const bf16_t* Bt, int M, int N, int K, const E& e) {
    pg8::Gemm g{A, Bt, M, N, K}; pg8::StaticOrder S; S.init(M, N, C.G, C.bid);
    EpiAdapt<E> EA{e};
    pg8::gemm_phase<EpiAdapt<E>, pg8::StaticOrder, true, true>((PG8_LAS unsigned char*)C.lds, g, S, EA);
    __syncthreads();
}
#ifndef FAST_GEMM
#define FAST_GEMM 1
#endif
#if FAST_GEMM
#define GEMM_CALL fast_gemm
#else
#define GEMM_CALL naive_gemm
#endif


template <int MODE> struct EpiRowStats {
    static constexpr bool PERM = true, AFTER_DRAIN = false;
    bf16_t* y; float* stats; const bf16_t* res; const float* st1; const float* g1; const float* b1;
    __device__ __forceinline__ void operator()(const pg8::f32x4 (&acc)[2][2][4][2], const pg8::Unit& u, int wr, int wc, int fr, int fq) const {
#pragma unroll
        for (int ai = 0; ai < 2; ++ai)
#pragma unroll
            for (int m = 0; m < 4; ++m) { const int row = u.pm * 256 + ai * 128 + wr * 64 + m * 16 + fr; float sm = 0.f, sq = 0.f;
                float mean1 = 0.f, rstd1 = 0.f;
                if (MODE == 1) { const float a = st1[2 * row], b = st1[2 * row + 1]; mean1 = a * (1.f / DM); rstd1 = 1.f / sqrtf(fmaxf(b * (1.f / DM) - mean1 * mean1, 0.f) + 1e-5f); }
#pragma unroll
                for (int bj = 0; bj < 2; ++bj) { const int col = u.pn * 256 + bj * 128 + wc * 32 + 8 * fq;
                    const u32x4 r8 = *(const u32x4*)(res + (size_t)row * DM + col);
                    float rv[8] = {bflo(r8.x), bfhi(r8.x), bflo(r8.y), bfhi(r8.y), bflo(r8.z), bfhi(r8.z), bflo(r8.w), bfhi(r8.w)};
                    if (MODE == 1) { const f32x4 ga = *(const f32x4*)(g1 + col), gb = *(const f32x4*)(g1 + col + 4), ba = *(const f32x4*)(b1 + col), bb = *(const f32x4*)(b1 + col + 4);
                        const float gg[8] = {ga[0], ga[1], ga[2], ga[3], gb[0], gb[1], gb[2], gb[3]}, be[8] = {ba[0], ba[1], ba[2], ba[3], bb[0], bb[1], bb[2], bb[3]};
#pragma unroll
                        for (int j = 0; j < 8; ++j) rv[j] = (rv[j] - mean1) * rstd1 * gg[j] + be[j]; }
                    float v[8];
#pragma unroll
                    for (int j = 0; j < 8; ++j) { v[j] = ALPHA * rv[j] + acc[ai][bj][m][j >> 2][j & 3]; sm += v[j]; sq += v[j] * v[j]; }
                    store8_bf16(y + (size_t)row * DM + col, v); }
                sm += __shfl_xor(sm, 16); sm += __shfl_xor(sm, 32); sq += __shfl_xor(sq, 16); sq += __shfl_xor(sq, 32);
                if (fq == 0) { atomicAdd(stats + 2 * row, sm); atomicAdd(stats + 2 * row + 1, sq); } }
    }
};
__device__ __forceinline__ void ln2_row(const bf16_t* yrow, const float* st, const float* g, const float* bt, float* orow, int lane) {
    const float mean = st[0] * (1.f / DM), rstd = 1.f / sqrtf(fmaxf(st[1] * (1.f / DM) - mean * mean, 0.f) + 1e-5f);
#pragma unroll
    for (int j = 0; j < 2; ++j) { const int c0 = j * 512 + lane * 8; const u32x4 r8 = *(const u32x4*)(yrow + c0);
        const float v[8] = {bflo(r8.x), bfhi(r8.x), bflo(r8.y), bfhi(r8.y), bflo(r8.z), bfhi(r8.z), bflo(r8.w), bfhi(r8.w)};
        const f32x4 ga = *(const f32x4*)(g + c0), gb = *(const f32x4*)(g + c0 + 4), ba = *(const f32x4*)(bt + c0), bb = *(const f32x4*)(bt + c0 + 4);
        *(f32x4*)(orow + c0) = (f32x4){(v[0] - mean) * rstd * ga[0] + ba[0], (v[1] - mean) * rstd * ga[1] + ba[1], (v[2] - mean) * rstd * ga[2] + ba[2], (v[3] - mean) * rstd * ga[3] + ba[3]};
        *(f32x4*)(orow + c0 + 4) = (f32x4){(v[4] - mean) * rstd * gb[0] + bb[0], (v[5] - mean) * rstd * gb[1] + bb[1], (v[6] - mean) * rstd * gb[2] + bb[2], (v[7] - mean) * rstd * gb[3] + bb[3]}; }
}
__device__ __forceinline__ void job_y1m_fast(Ctx& C) {
    const int gw = C.bid * NWAVES + C.wave, NGW = C.G * NWAVES;
    for (int o = gw; o < 2 * DM; o += NGW) { const int r = o >> 10, n = o & 1023; const bf16_t* mr = WSP(bf16_t, WS_MIXM) + (size_t)(14 + r) * DM; const bf16_t* wr_ = WSP(bf16_t, WS_WOUT) + (size_t)n * DM; float acc = 0.f;
#pragma unroll
        for (int j = 0; j < 2; ++j) { const int k0 = j * 512 + C.lane * 8; const u32x4 a = *(const u32x4*)(mr + k0), w = *(const u32x4*)(wr_ + k0);
            acc += bflo(a.x) * bflo(w.x) + bfhi(a.x) * bfhi(w.x) + bflo(a.y) * bflo(w.y) + bfhi(a.y) * bfhi(w.y) + bflo(a.z) * bflo(w.z) + bfhi(a.z) * bfhi(w.z) + bflo(a.w) * bflo(w.w) + bfhi(a.w) * bfhi(w.w); }
        acc = wave_sum(acc);
        if (C.lane == 0) WSP(float, WS_Y1M)[r * DM + n] = ALPHA * WSP(float, WS_H0M)[(14 + r) * DM + n] + acc; }
}
__device__ __forceinline__ void job_ameta_fast(Ctx& C) {
    const int gw = C.bid * NWAVES + C.wave, NGW = C.G * NWAVES;
    for (int n = gw; n < DFF; n += NGW) { const int nr = (n >> 7) * 256 + (n & 127); const bf16_t* wr_ = WSP(bf16_t, WS_WUP) + (size_t)nr * DM; const float* y = WSP(float, WS_Y1M);
        float d0 = 0.f, d1 = 0.f, s0 = 0.f, s1 = 0.f, q0 = 0.f, q1 = 0.f;
#pragma unroll
        for (int j = 0; j < 2; ++j) { const int k0 = j * 512 + C.lane * 8; const u32x4 w = *(const u32x4*)(wr_ + k0);
            const float wv[8] = {bflo(w.x), bfhi(w.x), bflo(w.y), bfhi(w.y), bflo(w.z), bfhi(w.z), bflo(w.w), bfhi(w.w)};
#pragma unroll
            for (int e = 0; e < 8; ++e) { const float a = y[k0 + e], b = y[DM + k0 + e]; d0 += a * wv[e]; d1 += b * wv[e]; s0 += a; s1 += b; q0 += a * a; q1 += b * b; } }
        d0 = wave_sum(d0); d1 = wave_sum(d1); s0 = wave_sum(s0); s1 = wave_sum(s1); q0 = wave_sum(q0); q1 = wave_sum(q1);
        if (C.lane == 0) { const float c1 = WSP(float, WS_C12)[nr], c2 = WSP(float, WS_C12)[NUP + nr];
            const float m0 = s0 * (1.f / DM), m1 = s1 * (1.f / DM), r0 = 1.f / sqrtf(fmaxf(q0 * (1.f / DM) - m0 * m0, 0.f) + 1e-5f), r1 = 1.f / sqrtf(fmaxf(q1 * (1.f / DM) - m1 * m1, 0.f) + 1e-5f);
            WSP(float, WS_AMETA)[n] = r0 * (d0 - m0 * c1) + c2; WSP(float, WS_AMETA)[DFF + n] = r1 * (d1 - m1 * c1) + c2; } }
}
#ifndef FUSE_LN
#define FUSE_LN 1
#endif

struct EpiYB { bf16_t* y; const bf16_t* res;
    __device__ __forceinline__ void operator()(int m, int n, const float (&v)[8]) const {
        const u32x4 r = *(const u32x4*)(res + (size_t)m * DM + n);
        const float w[8] = {ALPHA * bflo(r.x) + v[0], ALPHA * bfhi(r.x) + v[1], ALPHA * bflo(r.y) + v[2], ALPHA * bfhi(r.y) + v[3], ALPHA * bflo(r.z) + v[4], ALPHA * bfhi(r.z) + v[5], ALPHA * bflo(r.w) + v[6], ALPHA * bfhi(r.w) + v[7]};
        store8_bf16(y + (size_t)m * DM + n, w); } };
template <bool OUT_BF16> __device__ __forceinline__ void ln_row_b(const bf16_t* yrow, const float* g, const float* bt, void* orow, int lane, bf16_t* qrow = nullptr) {
    float v[16]; float sm = 0.f;
#pragma unroll
    for (int j = 0; j < 2; ++j) { const u32x4 r8 = *(const u32x4*)(yrow + j * 512 + lane * 8);
        v[8 * j] = bflo(r8.x); v[8 * j + 1] = bfhi(r8.x); v[8 * j + 2] = bflo(r8.y); v[8 * j + 3] = bfhi(r8.y); v[8 * j + 4] = bflo(r8.z); v[8 * j + 5] = bfhi(r8.z); v[8 * j + 6] = bflo(r8.w); v[8 * j + 7] = bfhi(r8.w); }
#pragma unroll
    for (int e = 0; e < 16; ++e) sm += v[e];
    const float mean = wave_sum(sm) * (1.f / DM); float sq = 0.f;
#pragma unroll
    for (int e = 0; e < 16; ++e) { v[e] -= mean; sq += v[e] * v[e]; }
    const float rstd = 1.f / sqrtf(wave_sum(sq) * (1.f / DM) + 1e-5f);
#pragma unroll
    for (int j = 0; j < 2; ++j) { const int c0 = j * 512 + lane * 8;
        const f32x4 ga = *(const f32x4*)(g + c0), gb = *(const f32x4*)(g + c0 + 4), ba = *(const f32x4*)(bt + c0), bb = *(const f32x4*)(bt + c0 + 4);
        const float o[8] = {v[8 * j] * rstd * ga[0] + ba[0], v[8 * j + 1] * rstd * ga[1] + ba[1], v[8 * j + 2] * rstd * ga[2] + ba[2], v[8 * j + 3] * rstd * ga[3] + ba[3],
                            v[8 * j + 4] * rstd * gb[0] + bb[0], v[8 * j + 5] * rstd * gb[1] + bb[1], v[8 * j + 6] * rstd * gb[2] + bb[2], v[8 * j + 7] * rstd * gb[3] + bb[3]};
        if (OUT_BF16) { store8_bf16((bf16_t*)orow + c0, o); if (USE_FP8 && qrow) store8_f8((unsigned char*)qrow + c0, o, 16.f); else if (EMU_FP8 && qrow) { float oq[8]; for (int e = 0; e < 8; ++e) oq[e] = q8(o[e], S_H1); store8_bf16(qrow + c0, oq); } }
        else { *(f32x4*)((float*)orow + c0) = (f32x4){o[0], o[1], o[2], o[3]}; *(f32x4*)((float*)orow + c0 + 4) = (f32x4){o[4], o[5], o[6], o[7]}; } }
}
__device__ __forceinline__ void job_ameta_fast2(Ctx& C) {
    const int gw = C.bid * NWAVES + C.wave, NGW = C.G * NWAVES;
    for (int n = gw; n < DFF; n += NGW) { const int nr = (n >> 7) * 256 + (n & 127); const bf16_t* wr_ = WSP(bf16_t, WS_WUP) + (size_t)nr * DM; const float* y = WSP(float, WS_H1M);
        float d0 = 0.f, d1 = 0.f;
#pragma unroll
        for (int j = 0; j < 2; ++j) { const int k0 = j * 512 + C.lane * 8; const u32x4 w = *(const u32x4*)(wr_ + k0);
            const float wv[8] = {bflo(w.x), bfhi(w.x), bflo(w.y), bfhi(w.y), bflo(w.z), bfhi(w.z), bflo(w.w), bfhi(w.w)};
#pragma unroll
            for (int e = 0; e < 8; ++e) { d0 += y[k0 + e] * wv[e]; d1 += y[DM + k0 + e] * wv[e]; } }
        d0 = wave_sum(d0); d1 = wave_sum(d1);
        if (C.lane == 0) { WSP(float, WS_AMETA)[n] = d0; WSP(float, WS_AMETA)[DFF + n] = d1; } }
}
__device__ __forceinline__ float gelu_fast(float x) { const float u = x * (0.7978845608028654f + 0.035677408136300125f * x * x); return x * __builtin_amdgcn_rcpf(1.f + __builtin_amdgcn_exp2f(-2.f * LOG2E * u)); }
__device__ __forceinline__ float dpp_prev(float xp, float x, int which) {
    const int xi = __float_as_int(x), pi = __float_as_int(xp);
    if (which == 1) { const int o = __builtin_amdgcn_update_dpp(0, pi, 0x121, 0xf, 0xf, true); return __int_as_float(__builtin_amdgcn_update_dpp(o, xi, 0x111, 0xf, 0xf, false)); }
    const int o = __builtin_amdgcn_update_dpp(0, pi, 0x122, 0xf, 0xf, true); return __int_as_float(__builtin_amdgcn_update_dpp(o, xi, 0x112, 0xf, 0xf, false));
}
struct EpiUpConv {
    static constexpr bool PERM = true, AFTER_DRAIN = false;
    bf16_t* act; float* fix; float* halo; const float* cw; const float* cb; LAS float* xch; const float* st1; const float* c12;
    __device__ __forceinline__ void operator()(const pg8::f32x4 (&acc_in)[2][2][4][2], const pg8::Unit& u, int wr, int wc, int fr, int fq) const {
        const int cl = wc * 32 + 8 * fq, hc = u.pn * 128 + cl, un = u.pm * 22 + u.pn;
        pg8::f32x4 (&acc)[2][2][4][2] = const_cast<pg8::f32x4 (&)[2][2][4][2]>(acc_in);
        asm volatile("" ::: "memory");
        float w0[8], w1[8], w2[8], bb[8];
#pragma unroll
        for (int j = 0; j < 8; ++j) { w0[j] = cw[hc + j]; w1[j] = cw[DFF + hc + j]; w2[j] = cw[2 * DFF + hc + j]; bb[j] = cb[hc + j]; }
        if (fr >= 14) {
#pragma unroll
            for (int ai = 0; ai < 2; ++ai) { LAS float* xr = xch + ((ai * 2 + wr) * 2 + (fr - 14)) * 128 + cl;
                *(LAS f32x4*)xr = acc[ai][0][3][0]; *(LAS f32x4*)(xr + 4) = acc[ai][0][3][1]; }
            if (wr == 1) { float* hr = halo + ((size_t)un * 2 + (fr - 14)) * 128 + cl; *(f32x4*)hr = acc[1][0][3][0]; *(f32x4*)(hr + 4) = acc[1][0][3][1]; }
        }
        asm volatile("s_waitcnt lgkmcnt(0)\n\ts_barrier" ::: "memory");
#pragma unroll
        for (int ai = 0; ai < 2; ++ai) {
            float xp[8];
            { const int sb = (wr == 1) ? ai * 2 : 1;
              const LAS float* xr = xch + (sb * 2 + (fr & 1)) * 128 + cl; const f32x4 t0 = *(const LAS f32x4*)xr, t1 = *(const LAS f32x4*)(xr + 4);
              xp[0] = t0[0]; xp[1] = t0[1]; xp[2] = t0[2]; xp[3] = t0[3]; xp[4] = t1[0]; xp[5] = t1[1]; xp[6] = t1[2]; xp[7] = t1[3]; }
#pragma unroll
            for (int m = 0; m < 4; ++m) {
                float o[8];
#pragma unroll
                for (int j = 0; j < 8; ++j) { const float x = acc[ai][0][m][j >> 2][j & 3]; const float p = (m == 0) ? xp[j] : acc[ai][0][m > 0 ? m - 1 : 0][j >> 2][j & 3];
                    const float a1 = dpp_prev(p, x, 1), a2 = dpp_prev(p, x, 2);
                    o[j] = gelu_fast(a2 * w0[j] + a1 * w1[j] + x * w2[j] + bb[j]) * acc[ai][1][m][j >> 2][j & 3]; if (EMU_FP8) o[j] = q8(o[j], S_ACT); }
                const int row = u.pm * 256 + ai * 128 + wr * 64 + m * 16 + fr;
                if (ai == 0 && wr == 0 && m == 0 && fr < 2) {
                    float* fx = fix + ((size_t)un * 2 + fr) * 256 + cl;
                    *(f32x4*)fx = acc[0][0][0][0]; *(f32x4*)(fx + 4) = acc[0][0][0][1]; *(f32x4*)(fx + 128) = acc[0][1][0][0]; *(f32x4*)(fx + 132) = acc[0][1][0][1];
                } else { if (USE_FP8) store8_f8((unsigned char*)act + (size_t)row * DFF + hc, o, 8.f); else store8_bf16(act + (size_t)row * DFF + hc, o); }
            }
        }
        asm volatile("s_waitcnt lgkmcnt(0)\n\ts_barrier" ::: "memory");
    }
};
__device__ __forceinline__ void fix_rows(Ctx& C, int pm) {
    const float* fix = WSP(float, WS_FIX); const float* halo = WSP(float, WS_HALO); const float* am = WSP(float, WS_AMETA); const float* cw = IN_(13); const float* cb = IN_(14);
    for (int e = C.tid; e < 2 * DFF; e += NTHR) {
        const int r = e / DFF, hc = e % DFF, pn = hc >> 7, cl = hc & 127, un = pm * 22 + pn;
        const float a0 = fix[((size_t)un * 2 + r) * 256 + cl], g0 = fix[((size_t)un * 2 + r) * 256 + 128 + cl];
        float a1, a2;
        if ((pm & 7) == 0) { a1 = (r == 0) ? am[DFF + hc] : fix[((size_t)un * 2) * 256 + cl]; a2 = (r == 0) ? am[hc] : am[DFF + hc]; }
        else { const float* h = halo + ((size_t)(un - 22) * 2) * 128 + cl; a1 = (r == 0) ? h[128] : fix[((size_t)un * 2) * 256 + cl]; a2 = (r == 0) ? h[0] : h[128]; }
        const float cv = a2 * cw[hc] + a1 * cw[DFF + hc] + a0 * cw[2 * DFF + hc] + cb[hc];
        { float av = gelu_fast(cv) * g0; if (USE_FP8) { const int p = __builtin_amdgcn_cvt_pk_fp8_f32(clamp8(av * 8.f), 0.f, 0, false); WSP(unsigned char, WS_ACT8)[(size_t)(pm * 256 + r) * DFF + hc] = (unsigned char)(p & 0xff); } else { if (EMU_FP8) av = q8(av, S_ACT); WSP(bf16_t, WS_ACT)[(size_t)(pm * 256 + r) * DFF + hc] = (bf16_t)f2bf(av); } }
    }
}

__device__ __forceinline__ void job_y1m_f8(Ctx& C) {
    const int gw = C.bid * NWAVES + C.wave, NGW = C.G * NWAVES;
    for (int o = gw; o < 2 * DM; o += NGW) { const int r = o >> 10, n = o & 1023; const bf16_t* mr = WSP(bf16_t, WS_MIXM) + (size_t)(14 + r) * DM; const unsigned char* wr_ = WSP(unsigned char, WS_WOUT8) + (size_t)n * DM;
        const int k0 = C.lane * 16; const u32x4 w = *(const u32x4*)(wr_ + k0); const u32x4 a0 = *(const u32x4*)(mr + k0), a1 = *(const u32x4*)(mr + k0 + 8);
        float acc = f8dot4(w.x, bflo(a0.x), bfhi(a0.x), bflo(a0.y), bfhi(a0.y)) + f8dot4(w.y, bflo(a0.z), bfhi(a0.z), bflo(a0.w), bfhi(a0.w))
                  + f8dot4(w.z, bflo(a1.x), bfhi(a1.x), bflo(a1.y), bfhi(a1.y)) + f8dot4(w.w, bflo(a1.z), bfhi(a1.z), bflo(a1.w), bfhi(a1.w));
        acc = wave_sum(acc) * (1.f / 64.f);
        if (C.lane == 0) WSP(float, WS_Y1M)[r * DM + n] = ALPHA * WSP(float, WS_H0M)[(14 + r) * DM + n] + acc; }
}
__device__ __forceinline__ void job_ameta_f8(Ctx& C) {
    const int gw = C.bid * NWAVES + C.wave, NGW = C.G * NWAVES;
    for (int n = gw; n < DFF; n += NGW) { const int nr = (n >> 7) * 256 + (n & 127); const unsigned char* wr_ = WSP(unsigned char, WS_WUP8) + (size_t)nr * DM; const float* y = WSP(float, WS_H1M);
        const int k0 = C.lane * 16; const u32x4 w = *(const u32x4*)(wr_ + k0); float d0 = 0.f, d1 = 0.f;
        const unsigned ww[4] = {w.x, w.y, w.z, w.w};
#pragma unroll
        for (int e = 0; e < 4; ++e) { const f32x4 ya = *(const f32x4*)(y + k0 + 4 * e), yb = *(const f32x4*)(y + DM + k0 + 4 * e); d0 += f8dot4(ww[e], ya[0], ya[1], ya[2], ya[3]); d1 += f8dot4(ww[e], yb[0], yb[1], yb[2], yb[3]); }
        d0 = wave_sum(d0) * (1.f / 64.f); d1 = wave_sum(d1) * (1.f / 64.f);
        if (C.lane == 0) { WSP(float, WS_AMETA)[n] = d0; WSP(float, WS_AMETA)[DFF + n] = d1; } }
}
template <class E, int SCA> __device__ __forceinline__ void fast_gemm_f8(Ctx& C, const void* A8, const void* B8, int M, int N, int Kbytes, const E& e) {
    pg8::Gemm g{(const bf16_t*)A8, (const bf16_t*)B8, M, N, Kbytes / 2}; pg8::StaticOrder S; S.init(M, N, C.G, C.bid);
    EpiAdapt<E> EA{e};
    pg8::gemm_phase<EpiAdapt<E>, pg8::StaticOrder, true, true, true, E_W, SCA>((PG8_LAS unsigned char*)C.lds, g, S, EA);
    __syncthreads();
}
#ifndef FUSE_CONV
#define FUSE_CONV 1
#endif
__device__ __forceinline__ unsigned sortable(float f) { const unsigned u = __float_as_uint(f); return (u & 0x80000000u) ? ~u : (u | 0x80000000u); }
__device__ __forceinline__ void phase_select_naive(Ctx& C) {
    LAS float* qs = (LAS float*)C.lds;
    LAS unsigned* keys = (LAS unsigned*)(C.lds + 2048);
    LAS unsigned* cntw = (LAS unsigned*)(C.lds + 2048 + 2112 * 4);
    const int tid = C.tid, lane = C.lane, wave = C.wave;
    const int NQ = BATCH * (NTILE - 4) * 64;
    for (int q = C.bid; q < NQ; q += C.G) {
        const int b = q / ((NTILE - 4) * 64), i = 256 + q % ((NTILE - 4) * 64), c = i >> 6, n = 64 * (c + 1);
        const bf16_t* qrow = WSP(bf16_t, WS_PROJ) + ((size_t)b * TP + i) * PC;
        __syncthreads();
#if PROBE_F32IDX
        { const float* qf = WSP(float, WS_IDX) + ((size_t)b * TP + i) * 384; if (tid < 256) qs[tid] = qf[tid]; else if (tid < 260) qs[tid] = qf[320 + tid - 256]; }
#else
        if (tid < 256) qs[tid] = bf2f(qrow[C_IQ + tid]); else if (tid < 260) qs[tid] = bf2f(qrow[C_IW + tid - 256]);
#endif
        if (tid < 8) cntw[tid] = 0u;
        __syncthreads();
#pragma unroll 1
        for (int e = tid; e < n; e += NTHR) {
            asm volatile("" ::: "memory");
            const u32x4* kp = (const u32x4*)(WSP(bf16_t, WS_PROJ) + ((size_t)b * TP + e) * PC + C_IK);
            float d0 = 0.f, d1 = 0.f, d2 = 0.f, d3 = 0.f;
#pragma unroll
            for (int j = 0; j < 8; ++j) { float kv[8];
#if PROBE_F32IDX
                { const f32x4* kf = (const f32x4*)(WSP(float, WS_IDX) + ((size_t)b * TP + e) * 384 + 256 + 8 * j); const f32x4 t0 = kf[0], t1 = kf[1];
                  kv[0] = t0[0]; kv[1] = t0[1]; kv[2] = t0[2]; kv[3] = t0[3]; kv[4] = t1[0]; kv[5] = t1[1]; kv[6] = t1[2]; kv[7] = t1[3]; }
#else
                const u32x4 t = kp[j]; kv[0] = bflo(t.x); kv[1] = bfhi(t.x); kv[2] = bflo(t.y); kv[3] = bfhi(t.y);
                kv[4] = bflo(t.z); kv[5] = bfhi(t.z); kv[6] = bflo(t.w); kv[7] = bfhi(t.w);
#endif
#pragma unroll
                for (int e2 = 0; e2 < 8; ++e2) { d0 += qs[8 * j + e2] * kv[e2]; d1 += qs[64 + 8 * j + e2] * kv[e2]; d2 += qs[128 + 8 * j + e2] * kv[e2]; d3 += qs[192 + 8 * j + e2] * kv[e2]; } }
            float sc = qs[256] * fmaxf(d0, 0.f) + qs[257] * fmaxf(d1, 0.f) + qs[258] * fmaxf(d2, 0.f) + qs[259] * fmaxf(d3, 0.f);
            sc = sc + 0.f;
            if (e < 48) sc = -INFINITY;
            keys[e] = sortable(sc);
        }
        __syncthreads();
        unsigned prefix = 0u;
        for (int bit = 31; bit >= 0; --bit) {
            const unsigned t = prefix | (1u << bit);
            unsigned my = 0u;
            for (int e = tid; e < n; e += NTHR) my += (keys[e] >= t) ? 1u : 0u;
            my = (unsigned)wave_sum((float)my);
            if (lane == 0 && my) atomicAdd((unsigned*)&cntw[bit & 1], my);
            __syncthreads();
            const unsigned tot = cntw[bit & 1];
            if (tid == 0) cntw[(bit & 1) ^ 1] = 0u;
            if (tot >= (unsigned)TOPK) prefix = t;
            __syncthreads();
        }
        {
            unsigned my = 0u;
            for (int e = tid; e < n; e += NTHR) my += (keys[e] >= prefix) ? 1u : 0u;
            my = (unsigned)wave_sum((float)my);
            if (tid == 0) { cntw[2] = 0u; }
            __syncthreads();
            if (lane == 0 && my) atomicAdd((unsigned*)&cntw[2], my);
            __syncthreads();
            const unsigned ge = cntw[2];
            if (ge != (unsigned)TOPK && tid == 0) {
                int drop = (int)ge - TOPK;
                for (int e = n - 1; e >= 0 && drop > 0; --e) if (keys[e] == prefix) { keys[e] = 0u; --drop; }
            }
            __syncthreads();
        }
        u64* mrow = WSP(u64, WS_MASK) + ((size_t)b * TP + i) * NTILE;
        for (int r = 0; r < 5; ++r) { const int t = wave + 8 * r; const int e = t * 64 + lane;
            const bool sel = (e < n) && (keys[e < n ? e : 0] >= prefix) && prefix != 0u;
            const u64 w = __ballot(sel);
            if (t <= c && lane == 0) mrow[t] = w; }
    }
    __syncthreads();
}

__device__ __forceinline__ float log_sigmoid(float x) { return fminf(x, 0.f) - log1pf(expf(-fabsf(x))); }
__device__ __forceinline__ void gla_naive_unit(Ctx& C, int b, int h) {
    LAS float* qs = (LAS float*)C.lds; LAS float* ks = qs + 4096; LAS float* as = ks + 4096; LAS float* vs = as + 4096; LAS float* os = vs + 8192;
    LAS float* red = os + 8192; LAS float* lrs = red + 1024;
    const int tid = C.tid, dv = tid & 127, kg = tid >> 7;
    float S[16];
#pragma unroll
    for (int r = 0; r < 16; ++r) S[r] = 0.f;
    float wg[16]; const int dg = tid & 63;
#pragma unroll
    for (int r = 0; r < 16; ++r) wg[r] = IN_(5)[r * 256 + h * 64 + dg];
    const float bgv = IN_(6)[h * 64 + dg];
#pragma unroll 1
    for (int c = 0; c < NTILE; ++c) {
        const size_t rb = (size_t)b * TP + c * 64;
        __syncthreads();
        { const int t = tid >> 3, d0 = (tid & 7) * 8; const bf16_t* row = WSP(bf16_t, WS_PROJ) + (rb + t) * PC;
          const u32x4 qv = *(const u32x4*)(row + C_BQ + h * 64 + d0), kv = *(const u32x4*)(row + C_BK + h * 64 + d0);
          LAS float* qd = qs + t * 64 + d0; LAS float* kd = ks + t * 64 + d0;
          qd[0] = bflo(qv.x); qd[1] = bfhi(qv.x); qd[2] = bflo(qv.y); qd[3] = bfhi(qv.y); qd[4] = bflo(qv.z); qd[5] = bfhi(qv.z); qd[6] = bflo(qv.w); qd[7] = bfhi(qv.w);
          kd[0] = bflo(kv.x); kd[1] = bfhi(kv.x); kd[2] = bflo(kv.y); kd[3] = bfhi(kv.y); kd[4] = bflo(kv.z); kd[5] = bfhi(kv.z); kd[6] = bflo(kv.w); kd[7] = bfhi(kv.w);
          const int e0 = (tid & 7) * 16; const u32x4 v0 = *(const u32x4*)(row + C_BV + h * 128 + e0), v1 = *(const u32x4*)(row + C_BV + h * 128 + e0 + 8);
          LAS float* vd = vs + t * 128 + e0;
          vd[0] = bflo(v0.x); vd[1] = bfhi(v0.x); vd[2] = bflo(v0.y); vd[3] = bfhi(v0.y); vd[4] = bflo(v0.z); vd[5] = bfhi(v0.z); vd[6] = bflo(v0.w); vd[7] = bfhi(v0.w);
          vd[8] = bflo(v1.x); vd[9] = bfhi(v1.x); vd[10] = bflo(v1.y); vd[11] = bfhi(v1.y); vd[12] = bflo(v1.z); vd[13] = bfhi(v1.z); vd[14] = bflo(v1.w); vd[15] = bfhi(v1.w);
          if (tid < 128) { const int t2 = tid >> 1, r0 = (tid & 1) * 8; const u32x4 lv = *(const u32x4*)(WSP(bf16_t, WS_PROJ) + (rb + t2) * PC + C_LR + r0); LAS float* ld = lrs + t2 * 16 + r0;
              ld[0] = bflo(lv.x); ld[1] = bfhi(lv.x); ld[2] = bflo(lv.y); ld[3] = bfhi(lv.y); ld[4] = bflo(lv.z); ld[5] = bfhi(lv.z); ld[6] = bflo(lv.w); ld[7] = bfhi(lv.w); } }
        __syncthreads();
        { const int tg = tid >> 6;
#pragma unroll
          for (int j = 0; j < 8; ++j) { const int t = tg * 8 + j; float x = bgv;
#pragma unroll
              for (int r = 0; r < 16; ++r) x += lrs[t * 16 + r] * wg[r];
              as[t * 64 + dg] = expf(log_sigmoid(x) * (1.f / 16.f)); } }
        __syncthreads();
#pragma unroll 1
        for (int t = 0; t < 64; ++t) {
            const float vv = vs[t * 128 + dv]; float part = 0.f;
#pragma unroll
            for (int r = 0; r < 16; ++r) { const int dk = kg * 16 + r; S[r] = as[t * 64 + dk] * S[r] + ks[t * 64 + dk] * vv; part += qs[t * 64 + dk] * S[r]; }
            LAS float* rd = red + (t & 1) * 512;
            rd[kg * 128 + dv] = part;
            __syncthreads();
            if (kg == 0) os[t * 128 + dv] = (rd[dv] + rd[128 + dv]) + (rd[256 + dv] + rd[384 + dv]);
        }
        __syncthreads();
        { const int t = tid >> 3, sub = tid & 7, i = c * 64 + t; float o[16]; float ss = 0.f;
#pragma unroll
          for (int j = 0; j < 16; ++j) { o[j] = os[t * 128 + sub * 16 + j]; ss += o[j] * o[j]; }
          ss += __shfl_xor(ss, 1); ss += __shfl_xor(ss, 2); ss += __shfl_xor(ss, 4);
          const float rstd = 1.f / sqrtf(ss * (1.f / 128.f) + 1e-6f);
          if (i >= 48) {
              const bf16_t* ogp = WSP(bf16_t, WS_PROJ) + (rb + t) * PC + C_OG + h * 128 + sub * 16;
              bf16_t* dst = (i >= 64) ? WSP(bf16_t, WS_MIXED) + ((size_t)b * SEQ + (i - 64)) * DM + 512 + h * 128 + sub * 16 : WSP(bf16_t, WS_MIXM) + ((size_t)b * 16 + (i - 48)) * DM + 512 + h * 128 + sub * 16;
              float w[16];
#pragma unroll
              for (int j = 0; j < 16; ++j) { const float g = bf2f(ogp[j]); const float sl = g / (1.f + expf(-g)); w[j] = o[j] * rstd * IN_(8)[h * 128 + sub * 16 + j] * sl; }
              float w0[8], w1[8];
#pragma unroll
              for (int j = 0; j < 8; ++j) { w0[j] = w[j]; w1[j] = w[8 + j]; }
              store8_bf16(dst, w0); store8_bf16(dst + 8, w1);
          } }
    }
    __syncthreads();
}

__device__ __forceinline__ void phase_attn_naive(Ctx& C) {
    LAS float* lg = (LAS float*)C.lds;
    LAS float* qs = lg + 8 * TP;
    const int tid = C.tid, lane = C.lane, h = C.wave;
    const float slope2 = exp2f(-(float)(h + 1)) * LOG2E;
    const int NQ = BATCH * (TP - 48);
    for (int q = C.bid; q < NQ; q += C.G) {
        const int b = q / (TP - 48), i = 48 + q % (TP - 48), c = i >> 6;
        const bf16_t* qrow = WSP(bf16_t, WS_PROJ) + ((size_t)b * TP + i) * PC;
        __syncthreads();
        qs[tid] = bf2f(qrow[C_AQ + tid]);
        __syncthreads();
        const u64* mrow = WSP(u64, WS_MASK) + ((size_t)b * TP + i) * NTILE;
        float mx = -INFINITY;
        for (int t = 0; t <= c; ++t) {
            const u64 w = mrow[t]; const int j = t * 64 + lane; float l = -INFINITY;
            if ((w >> lane) & 1ull) {
                const u32x4* kp = (const u32x4*)(WSP(bf16_t, WS_PROJ) + ((size_t)b * TP + j) * PC + C_AK + h * 64); float d = 0.f;
#pragma unroll
                for (int jj = 0; jj < 8; ++jj) { const u32x4 kk = kp[jj]; const LAS float* qq = qs + h * 64 + jj * 8;
                    d += qq[0] * bflo(kk.x) + qq[1] * bfhi(kk.x) + qq[2] * bflo(kk.y) + qq[3] * bfhi(kk.y) + qq[4] * bflo(kk.z) + qq[5] * bfhi(kk.z) + qq[6] * bflo(kk.w) + qq[7] * bfhi(kk.w); }
                const int dist = i > j ? i - j : j - i;
                l = d - slope2 * (float)dist;
            }
            lg[h * TP + j] = l; mx = fmaxf(mx, l);
        }
        mx = wave_max(mx);
        float sum = 0.f;
        for (int t = 0; t <= c; ++t) { const int j = t * 64 + lane; const float l = lg[h * TP + j]; const float p = (l == -INFINITY) ? 0.f : exp2f(l - mx); lg[h * TP + j] = p; sum += p; }
        sum = wave_sum(sum);
        LDS_WAIT();
        float acc = 0.f;
        for (int t = 0; t <= c; ++t) {
            const u64 w = mrow[t];
            unsigned lo = __builtin_amdgcn_readfirstlane((unsigned)w), hi = __builtin_amdgcn_readfirstlane((unsigned)(w >> 32));
            const bf16_t* vb = WSP(bf16_t, WS_PROJ) + ((size_t)b * TP + t * 64) * PC + C_AV + h * 64 + lane;
            while (lo) { const int k = __builtin_ctz(lo); lo &= lo - 1u; acc += lg[h * TP + t * 64 + k] * bf2f(vb[(size_t)k * PC]); }
            while (hi) { const int k = 32 + __builtin_ctz(hi); hi &= hi - 1u; acc += lg[h * TP + t * 64 + k] * bf2f(vb[(size_t)k * PC]); }
        }
        const float o = acc / sum;
        const float ms = wave_sum(o * o) * (1.f / 64.f);
        const float val = o * (1.f / sqrtf(ms + 1e-6f)) * IN_(7)[h * 64 + lane];
        bf16_t* dst = (i >= 64) ? WSP(bf16_t, WS_MIXED) + ((size_t)b * SEQ + (i - 64)) * DM + h * 64 + lane : WSP(bf16_t, WS_MIXM) + ((size_t)b * 16 + (i - 48)) * DM + h * 64 + lane;
        *dst = (bf16_t)f2bf(val);
    }
    __syncthreads();
}


namespace gla {
typedef short bf16x8 __attribute__((ext_vector_type(8)));
typedef short bf16x4 __attribute__((ext_vector_type(4)));
typedef float f32x16 __attribute__((ext_vector_type(16)));
constexpr int RP = 144;
constexpr int L_QT = 0, L_KT = L_QT + 64 * RP, L_KH = L_KT + 64 * RP, L_VT = L_KH + 64 * RP, L_ST = L_VT + 128 * RP, L_GT = L_ST + 128 * RP;
constexpr int L_DL = L_GT + 8 * 64 * 4, L_WG = L_DL + 256, L_OS = L_WG + 16 * 64 * 4, OSP = 132, L_END = L_OS + 64 * OSP * 4;
static_assert(L_END <= 131072, "gla LDS");
__device__ __forceinline__ int crow(int r, int hi) { return (r & 3) + 8 * (r >> 2) + 4 * hi; }
__device__ __forceinline__ unsigned cvtpk(float lo, float hi) { typedef float f2 __attribute__((ext_vector_type(2))); typedef __bf16 b2 __attribute__((ext_vector_type(2))); f2 v = {lo, hi}; b2 b = __builtin_convertvector(v, b2); return __builtin_bit_cast(unsigned, b); }
__device__ __forceinline__ float logsig(float x) { return fminf(x, 0.f) - __logf(1.f + __expf(-fabsf(x))); }

__device__ __forceinline__ void gla_unit(Ctx& C, int b, int h) {
    const int tid = C.tid, lane = C.lane, wid = C.wave, r32 = lane & 31, hi = lane >> 5;
    const int t = tid >> 3, d8 = (tid & 7) * 8, dv16 = (tid & 7) * 16;
    const int tb = wid >> 2, db = wid & 3;
    LAS unsigned char* L = C.lds;
    LAS float* GT = (LAS float*)(L + L_GT); LAS float* DL = (LAS float*)(L + L_DL); LAS float* WG = (LAS float*)(L + L_WG); LAS float* OS = (LAS float*)(L + L_OS);
    const bf16_t* P = WSP(bf16_t, WS_PROJ) + (size_t)b * TP * PC;
    __syncthreads();
    for (int e = tid; e < 16 * 64; e += NTHR) WG[e] = IN_(5)[(e >> 6) * 256 + h * 64 + (e & 63)];
    for (int e = tid; e < 128 * RP / 4; e += NTHR) ((LAS unsigned*)(L + L_ST))[e] = 0u;
    float bg8[8];
#pragma unroll
    for (int j = 0; j < 8; ++j) bg8[j] = IN_(6)[h * 64 + d8 + j];
    float gn16[16];
#pragma unroll
    for (int j = 0; j < 16; ++j) gn16[j] = IN_(8)[h * 128 + dv16 + j];
    f32x16 Sacc = f32x16{};
    const bf16_t* row0 = P + (size_t)t * PC;
    u32x4 nq = *(const u32x4*)(row0 + C_BQ + h * 64 + d8), nk = *(const u32x4*)(row0 + C_BK + h * 64 + d8);
    u32x4 nl0 = *(const u32x4*)(row0 + C_LR), nl1 = *(const u32x4*)(row0 + C_LR + 8);
    u32x4 nv0 = *(const u32x4*)(row0 + C_BV + h * 128 + dv16), nv1 = *(const u32x4*)(row0 + C_BV + h * 128 + dv16 + 8);
    u32x4 ng0 = *(const u32x4*)(row0 + C_OG + h * 128 + dv16), ng1 = *(const u32x4*)(row0 + C_OG + h * 128 + dv16 + 8);
    __syncthreads();
#pragma unroll 1
    for (int c = 0; c < NTILE; ++c) {
        const u32x4 cq = nq, ck = nk, cl0 = nl0, cl1 = nl1, cv0 = nv0, cv1 = nv1, cg0 = ng0, cg1 = ng1;
        if (c + 1 < NTILE) { const bf16_t* row = P + (size_t)((c + 1) * 64 + t) * PC;
            nq = *(const u32x4*)(row + C_BQ + h * 64 + d8); nk = *(const u32x4*)(row + C_BK + h * 64 + d8);
            nl0 = *(const u32x4*)(row + C_LR); nl1 = *(const u32x4*)(row + C_LR + 8);
            nv0 = *(const u32x4*)(row + C_BV + h * 128 + dv16); nv1 = *(const u32x4*)(row + C_BV + h * 128 + dv16 + 8);
            ng0 = *(const u32x4*)(row + C_OG + h * 128 + dv16); ng1 = *(const u32x4*)(row + C_OG + h * 128 + dv16 + 8); }
        float g[8];
        { const float lf[16] = {bflo(cl0.x), bfhi(cl0.x), bflo(cl0.y), bfhi(cl0.y), bflo(cl0.z), bfhi(cl0.z), bflo(cl0.w), bfhi(cl0.w), bflo(cl1.x), bfhi(cl1.x), bflo(cl1.y), bfhi(cl1.y), bflo(cl1.z), bfhi(cl1.z), bflo(cl1.w), bfhi(cl1.w)};
#pragma unroll
          for (int j = 0; j < 8; ++j) g[j] = bg8[j];
#pragma unroll
          for (int r = 0; r < 16; ++r) { const f32x4 w0 = *(const LAS f32x4*)(WG + r * 64 + d8), w1 = *(const LAS f32x4*)(WG + r * 64 + d8 + 4);
              g[0] += lf[r] * w0[0]; g[1] += lf[r] * w0[1]; g[2] += lf[r] * w0[2]; g[3] += lf[r] * w0[3]; g[4] += lf[r] * w1[0]; g[5] += lf[r] * w1[1]; g[6] += lf[r] * w1[2]; g[7] += lf[r] * w1[3]; }
#pragma unroll
          for (int j = 0; j < 8; ++j) g[j] = logsig(g[j]) * (1.f / 16.f); }
#pragma unroll
        for (int off = 8; off < 64; off <<= 1) {
#pragma unroll
            for (int j = 0; j < 8; ++j) { const float tv = __shfl_up(g[j], off); if (lane >= off) g[j] += tv; } }
        if (lane >= 56) {
#pragma unroll
            for (int j = 0; j < 8; ++j) GT[wid * 64 + d8 + j] = g[j]; }
        __syncthreads();
        { float offs[8], bl[8];
#pragma unroll
          for (int j = 0; j < 8; ++j) { offs[j] = 0.f; bl[j] = 0.f; }
#pragma unroll
          for (int w2 = 0; w2 < 8; ++w2) { const f32x4 a0 = *(const LAS f32x4*)(GT + w2 * 64 + d8), a1 = *(const LAS f32x4*)(GT + w2 * 64 + d8 + 4);
              const float av[8] = {a0[0], a0[1], a0[2], a0[3], a1[0], a1[1], a1[2], a1[3]};
#pragma unroll
              for (int j = 0; j < 8; ++j) { bl[j] += av[j]; if (w2 < wid) offs[j] += av[j]; } }
          const float qv[8] = {bflo(cq.x), bfhi(cq.x), bflo(cq.y), bfhi(cq.y), bflo(cq.z), bfhi(cq.z), bflo(cq.w), bfhi(cq.w)};
          const float kv[8] = {bflo(ck.x), bfhi(ck.x), bflo(ck.y), bfhi(ck.y), bflo(ck.z), bfhi(ck.z), bflo(ck.w), bfhi(ck.w)};
          float qt_[8], kt_[8], kh_[8];
#pragma unroll
          for (int j = 0; j < 8; ++j) { const float bb = g[j] + offs[j]; const float eb = __expf(bb); qt_[j] = qv[j] * eb; kt_[j] = kv[j] * __expf(-bb); kh_[j] = kv[j] * __expf(bl[j] - bb); }
          *(LAS u32x4*)(L + L_QT + t * RP + d8 * 2) = (u32x4){cvtpk(qt_[0], qt_[1]), cvtpk(qt_[2], qt_[3]), cvtpk(qt_[4], qt_[5]), cvtpk(qt_[6], qt_[7])};
          *(LAS u32x4*)(L + L_KT + t * RP + d8 * 2) = (u32x4){cvtpk(kt_[0], kt_[1]), cvtpk(kt_[2], kt_[3]), cvtpk(kt_[4], kt_[5]), cvtpk(kt_[6], kt_[7])};
#pragma unroll
          for (int j = 0; j < 8; ++j) *(LAS unsigned short*)(L + L_KH + (d8 + j) * RP + t * 2) = (unsigned short)f2bf(kh_[j]);
          if (t == 0) {
#pragma unroll
              for (int j = 0; j < 8; ++j) DL[d8 + j] = __expf(bl[j]); }
          const unsigned vw[8] = {cv0.x, cv0.y, cv0.z, cv0.w, cv1.x, cv1.y, cv1.z, cv1.w};
#pragma unroll
          for (int j = 0; j < 8; ++j) { *(LAS unsigned short*)(L + L_VT + (dv16 + 2 * j) * RP + t * 2) = (unsigned short)(vw[j] & 0xffffu);
                                         *(LAS unsigned short*)(L + L_VT + (dv16 + 2 * j + 1) * RP + t * 2) = (unsigned short)(vw[j] >> 16); } }
        __syncthreads();
        f32x16 o = f32x16{};
        { bf16x8 qf[4];
#pragma unroll
          for (int ks = 0; ks < 4; ++ks) qf[ks] = *(const LAS bf16x8*)(L + L_QT + (32 * tb + r32) * RP + (16 * ks + 8 * hi) * 2);
#pragma unroll
          for (int ks = 0; ks < 4; ++ks) { const bf16x8 sf = *(const LAS bf16x8*)(L + L_ST + (32 * db + r32) * RP + (16 * ks + 8 * hi) * 2); o = __builtin_amdgcn_mfma_f32_32x32x16_bf16(qf[ks], sf, o, 0, 0, 0); }
          for (int jb = 0; jb <= tb; ++jb) {
              f32x16 p = f32x16{};
#pragma unroll
              for (int ks = 0; ks < 4; ++ks) { const bf16x8 kf = *(const LAS bf16x8*)(L + L_KT + (32 * jb + r32) * RP + (16 * ks + 8 * hi) * 2); p = __builtin_amdgcn_mfma_f32_32x32x16_bf16(kf, qf[ks], p, 0, 0, 0); }
              if (jb == tb) {
#pragma unroll
                  for (int r = 0; r < 16; ++r) if (crow(r, hi) > r32) p[r] = 0.f; }
              const u32x4 pw0 = (u32x4){cvtpk(p[0], p[1]), cvtpk(p[2], p[3]), cvtpk(p[4], p[5]), cvtpk(p[6], p[7])};
              const u32x4 pw1 = (u32x4){cvtpk(p[8], p[9]), cvtpk(p[10], p[11]), cvtpk(p[12], p[13]), cvtpk(p[14], p[15])};
              const LAS unsigned char* vrow = L + L_VT + (32 * db + r32) * RP + (32 * jb + 4 * hi) * 2;
              const bf16x4 a0 = *(const LAS bf16x4*)(vrow), a1 = *(const LAS bf16x4*)(vrow + 16), a2 = *(const LAS bf16x4*)(vrow + 32), a3 = *(const LAS bf16x4*)(vrow + 48);
              const bf16x8 v0 = (bf16x8){a0[0], a0[1], a0[2], a0[3], a1[0], a1[1], a1[2], a1[3]}, v1 = (bf16x8){a2[0], a2[1], a2[2], a2[3], a3[0], a3[1], a3[2], a3[3]};
              o = __builtin_amdgcn_mfma_f32_32x32x16_bf16(__builtin_bit_cast(bf16x8, pw0), v0, o, 0, 0, 0);
              o = __builtin_amdgcn_mfma_f32_32x32x16_bf16(__builtin_bit_cast(bf16x8, pw1), v1, o, 0, 0, 0);
          }
#pragma unroll
          for (int r = 0; r < 16; ++r) Sacc[r] *= DL[32 * tb + crow(r, hi)];
#pragma unroll
          for (int ks = 0; ks < 4; ++ks) { const bf16x8 af = *(const LAS bf16x8*)(L + L_KH + (32 * tb + r32) * RP + (16 * ks + 8 * hi) * 2);
              const bf16x8 bf = *(const LAS bf16x8*)(L + L_VT + (32 * db + r32) * RP + (16 * ks + 8 * hi) * 2); Sacc = __builtin_amdgcn_mfma_f32_32x32x16_bf16(af, bf, Sacc, 0, 0, 0); } }
        __syncthreads();
#pragma unroll
        for (int rg = 0; rg < 4; ++rg) { typedef unsigned u32x2 __attribute__((ext_vector_type(2)));
            *(LAS u32x2*)(L + L_ST + (32 * db + r32) * RP + (32 * tb + 8 * rg + 4 * hi) * 2) = (u32x2){cvtpk(Sacc[4 * rg], Sacc[4 * rg + 1]), cvtpk(Sacc[4 * rg + 2], Sacc[4 * rg + 3])}; }
#pragma unroll
        for (int r = 0; r < 16; ++r) OS[(32 * tb + crow(r, hi)) * OSP + 32 * db + r32] = o[r];
        __syncthreads();
        { const int i = c * 64 + t; float ov[16]; float ss = 0.f;
#pragma unroll
          for (int j4 = 0; j4 < 4; ++j4) { const f32x4 x4 = *(const LAS f32x4*)(OS + t * OSP + dv16 + 4 * j4); ov[4 * j4] = x4[0]; ov[4 * j4 + 1] = x4[1]; ov[4 * j4 + 2] = x4[2]; ov[4 * j4 + 3] = x4[3];
              ss += (x4[0] * x4[0] + x4[1] * x4[1]) + (x4[2] * x4[2] + x4[3] * x4[3]); }
          ss += __shfl_xor(ss, 1); ss += __shfl_xor(ss, 2); ss += __shfl_xor(ss, 4);
          const float rstd = 1.f / sqrtf(ss * (1.f / 128.f) + 1e-6f);
          if (i >= 48) {
              const unsigned gw[8] = {cg0.x, cg0.y, cg0.z, cg0.w, cg1.x, cg1.y, cg1.z, cg1.w};
              float w[16];
#pragma unroll
              for (int j = 0; j < 8; ++j) { const float ga = bflo(gw[j]), gb = bfhi(gw[j]);
                  w[2 * j] = ov[2 * j] * rstd * gn16[2 * j] * (ga / (1.f + __expf(-ga))); w[2 * j + 1] = ov[2 * j + 1] * rstd * gn16[2 * j + 1] * (gb / (1.f + __expf(-gb))); }
              bf16_t* dst = (i >= 64) ? WSP(bf16_t, WS_MIXED) + ((size_t)b * SEQ + (i - 64)) * DM + 512 + h * 128 + dv16 : WSP(bf16_t, WS_MIXM) + ((size_t)b * 16 + (i - 48)) * DM + 512 + h * 128 + dv16;
              float w0[8], w1[8];
#pragma unroll
              for (int j = 0; j < 8; ++j) { w0[j] = w[j]; w1[j] = w[8 + j]; }
              if (i >= 64) { if (USE_FP8) { unsigned char* d8 = WSP(unsigned char, WS_MIX8) + ((size_t)b * SEQ + (i - 64)) * DM + 512 + h * 128 + dv16; store8_f8(d8, w0, 16.f); store8_f8(d8 + 8, w1, 16.f); } else { store8_mix(dst, w0); store8_mix(dst + 8, w1); } } else { store8_bf16(dst, w0); store8_bf16(dst + 8, w1); }
          } }
    }
    __syncthreads();
}
}
#ifndef FAST_GLA
#define FAST_GLA 1
#endif
#ifndef GLA_SEP
#define GLA_SEP 0
#endif
#ifndef SELB_N
#define SELB_N 2
#endif
#ifndef SELA_REP
#define SELA_REP 1
#endif
#ifndef SELB_REP
#define SELB_REP 1
#endif
namespace sel {
typedef short bf16x8 __attribute__((ext_vector_type(8)));
constexpr int SCP = 2116;
constexpr int CW_QSEL = 64;
__device__ __forceinline__ unsigned unsortable(unsigned u) { return (u & 0x80000000u) ? (u & 0x7fffffffu) : ~u; }
__device__ __forceinline__ unsigned wave_min_u(unsigned v) {
#pragma unroll
    for (int o = 1; o < 64; o <<= 1) { const unsigned t = (unsigned)__shfl_xor((int)v, o); v = t < v ? t : v; }
    return v; }
__device__ __forceinline__ unsigned wave_max_u(unsigned v) {
#pragma unroll
    for (int o = 1; o < 64; o <<= 1) { const unsigned t = (unsigned)__shfl_xor((int)v, o); v = t > v ? t : v; }
    return v; }

#define DPP_RED(v, OP) do { v = OP(v, (unsigned)__builtin_amdgcn_update_dpp((int)v, (int)v, 0xB1, 0xf, 0xf, false)); v = OP(v, (unsigned)__builtin_amdgcn_update_dpp((int)v, (int)v, 0x4E, 0xf, 0xf, false)); \
    v = OP(v, (unsigned)__builtin_amdgcn_update_dpp((int)v, (int)v, 0x141, 0xf, 0xf, false)); v = OP(v, (unsigned)__builtin_amdgcn_update_dpp((int)v, (int)v, 0x140, 0xf, 0xf, false)); } while (0)
__device__ __forceinline__ unsigned uadd(unsigned a, unsigned b) { return a + b; }
__device__ __forceinline__ unsigned umin_(unsigned a, unsigned b) { return a < b ? a : b; }
__device__ __forceinline__ unsigned umax_(unsigned a, unsigned b) { return a > b ? a : b; }
__device__ __forceinline__ unsigned wave_add_dpp(unsigned v) { DPP_RED(v, uadd); return (unsigned)__builtin_amdgcn_readlane((int)v, 0) + (unsigned)__builtin_amdgcn_readlane((int)v, 16) + (unsigned)__builtin_amdgcn_readlane((int)v, 32) + (unsigned)__builtin_amdgcn_readlane((int)v, 48); }
__device__ __forceinline__ unsigned wave_min_dpp(unsigned v) { DPP_RED(v, umin_); return umin_(umin_((unsigned)__builtin_amdgcn_readlane((int)v, 0), (unsigned)__builtin_amdgcn_readlane((int)v, 16)), umin_((unsigned)__builtin_amdgcn_readlane((int)v, 32), (unsigned)__builtin_amdgcn_readlane((int)v, 48))); }
__device__ __forceinline__ unsigned wave_max_dpp(unsigned v) { DPP_RED(v, umax_); return umax_(umax_((unsigned)__builtin_amdgcn_readlane((int)v, 0), (unsigned)__builtin_amdgcn_readlane((int)v, 16)), umax_((unsigned)__builtin_amdgcn_readlane((int)v, 32), (unsigned)__builtin_amdgcn_readlane((int)v, 48))); }
#ifndef BIS_REP
#define BIS_REP 1
#endif
#ifndef ITER_PROBE
#define ITER_PROBE 0
#endif
#ifndef SEL_VALU_COUNT
#define SEL_VALU_COUNT 1
#endif
template <int NS> __device__ __forceinline__ void select_query(Ctx& C, LAS float* scq, int c, u64* mrow) {
    const int lane = C.lane;
    unsigned k[NS];
    unsigned kmin = 0xFFFFFFFFu, kmax = 0u;
#pragma unroll
    for (int s = 0; s < NS; ++s) {
        if (s <= c) { k[s] = sortable(scq[64 * s + lane]); kmax = k[s] > kmax ? k[s] : kmax; if (s >= 1) kmin = k[s] < kmin ? k[s] : kmin; }
        else k[s] = 0u;
    }
    kmin = wave_min_dpp(kmin); kmax = wave_max_dpp(kmax);
    unsigned lo = kmin, hi = kmax + 1u, cnt_hi = 0u, thr = 0u;
    bool exact = false; int it_done = 0;
#pragma unroll 1
    for (int brep = 0; brep < BIS_REP; ++brep) { lo = kmin; hi = kmax + 1u; cnt_hi = 0u; exact = false;
    for (int it = 0; it < 48; ++it) {
        if (hi - lo <= 1u) break;
        it_done = it + 1;
        unsigned mid = lo + ((hi - lo) >> 1);
        if (it < 12) { const float fm = 0.5f * __uint_as_float(unsortable(lo)) + 0.5f * __uint_as_float(unsortable(hi)); const unsigned mk = sortable(fm); if (mk > lo && mk < hi) mid = mk; }
        unsigned cnt = 0u;
#if SEL_VALU_COUNT
        { unsigned c0 = 0u, c1 = 0u, c2 = 0u, c3 = 0u;
#pragma unroll
          for (int s = 0; s < NS; ++s) { const unsigned inc = (k[s] >= mid) ? 1u : 0u; if ((s & 3) == 0) c0 += inc; else if ((s & 3) == 1) c1 += inc; else if ((s & 3) == 2) c2 += inc; else c3 += inc; }
          cnt = wave_add_dpp((c0 + c1) + (c2 + c3)); }
#else
#pragma unroll
        for (int s = 0; s < NS; ++s) { cnt += (unsigned)__popcll(__ballot(k[s] >= mid)); if ((s & 7) == 7) __builtin_amdgcn_sched_barrier(0); }
#endif
        if (cnt == (unsigned)TOPK) { exact = true; thr = mid; break; }
        if (cnt > (unsigned)TOPK) lo = mid; else { hi = mid; cnt_hi = cnt; }
    }
    asm volatile("" : "+s"(lo), "+s"(hi));
    }
#if ITER_PROBE
    if (lane == 0) atomicAdd((unsigned*)C.a->ws + 96, (unsigned)it_done);
#endif
    unsigned need = 0u;
    if (!exact) { thr = lo; need = (unsigned)TOPK - cnt_hi; }
    u64 myw = 0ull;
#pragma unroll
    for (int s = 0; s < NS; ++s) {
        u64 w;
        if (exact) w = __ballot(k[s] >= thr);
        else {
            w = __ballot(k[s] > thr);
            u64 eq = __ballot(k[s] == thr);
            const unsigned ce = (unsigned)__popcll(eq);
            if (ce <= need) { w |= eq; need -= ce; }
            else { while (need) { const u64 bit = eq & (0ull - eq); w |= bit; eq ^= bit; --need; } }
        }
        if (lane == s) myw = w;
        __builtin_amdgcn_sched_barrier(0);
    }
    if (lane <= c) mrow[lane] = myw;
}

#ifndef SEL_NOCMP
#define SEL_NOCMP 0
#endif
__device__ __forceinline__ float wave_fmin_dpp(float v) { unsigned u = sortable(v); u = wave_min_dpp(u); return __uint_as_float(unsortable(u)); }
__device__ __forceinline__ float wave_fmax_dpp(float v) { unsigned u = sortable(v); u = wave_max_dpp(u); return __uint_as_float(unsortable(u)); }
template <int NS> __device__ __forceinline__ void select_query2(Ctx& C, LAS float* scA, LAS float* scB, int c, u64* mrowA, u64* mrowB) {
    const int lane = C.lane;
    float fA[NS], fB[NS];
    float mnA = INFINITY, mxA = -INFINITY, mnB = INFINITY, mxB = -INFINITY;
#pragma unroll
    for (int s = 0; s < NS; ++s) {
        if (s <= c) { fA[s] = scA[64 * s + lane]; fB[s] = scB[64 * s + lane]; mxA = fmaxf(mxA, fA[s]); mxB = fmaxf(mxB, fB[s]); if (s >= 1) { mnA = fminf(mnA, fA[s]); mnB = fminf(mnB, fB[s]); } }
        else { fA[s] = -INFINITY; fB[s] = -INFINITY; }
    }
    unsigned loA = sortable(wave_fmin_dpp(mnA)), hiA = sortable(wave_fmax_dpp(mxA)) + 1u, loB = sortable(wave_fmin_dpp(mnB)), hiB = sortable(wave_fmax_dpp(mxB)) + 1u;
    unsigned chA = 0u, chB = 0u, thrA = 0u, thrB = 0u; bool exA = false, exB = false, dnA = false, dnB = false;
    float clA = (float)(64 * c + 16), clB = clA; int sdA = 0, sdB = 0, itp = 0;
    for (int it = 0; it < 48; ++it) {
        if (!dnA && hiA - loA <= 1u) dnA = true;
        if (!dnB && hiB - loB <= 1u) dnB = true;
        if (dnA && dnB) break;
        itp = it + 1;
        unsigned midA = loA + ((hiA - loA) >> 1), midB = loB + ((hiB - loB) >> 1);
        if (it < 16) {
            const float la = __uint_as_float(unsortable(loA)), ha = __uint_as_float(unsortable(hiA)), lb = __uint_as_float(unsortable(loB)), hb = __uint_as_float(unsortable(hiB));
            float fra = 0.5f, frb = 0.5f;
            if (it >= 2 && sdA < 2 && sdA > -2) { fra = (clA - 256.f) / (clA - (float)chA); fra = fminf(fmaxf(fra, 0.06f), 0.94f); }
            if (it >= 2 && sdB < 2 && sdB > -2) { frb = (clB - 256.f) / (clB - (float)chB); frb = fminf(fmaxf(frb, 0.06f), 0.94f); }
            const unsigned ma = sortable(la + fra * (ha - la)), mb = sortable(lb + frb * (hb - lb));
            if (ma > loA && ma < hiA) midA = ma;
            if (mb > loB && mb < hiB) midB = mb; }
        const float tA = __uint_as_float(unsortable(midA)), tB = __uint_as_float(unsortable(midB));
        unsigned a0 = 0u, a1 = 0u, b0 = 0u, b1 = 0u;
#pragma unroll
        for (int s = 0; s < NS; ++s) { const unsigned ia = __float_as_uint(fA[s] - tA) >> 31, ib = __float_as_uint(fB[s] - tB) >> 31; if (s & 1) { a1 += ia; b1 += ib; } else { a0 += ia; b0 += ib; } }
        unsigned pk = (a0 + a1) | ((b0 + b1) << 16);
        pk = wave_add_dpp(pk);
        const unsigned cntA = (unsigned)(NS * 64) - (pk & 0xffffu), cntB = (unsigned)(NS * 64) - (pk >> 16);
        if (!dnA) { if (cntA == (unsigned)TOPK) { exA = true; thrA = midA; dnA = true; } else if (cntA > (unsigned)TOPK) { loA = midA; clA = (float)cntA; sdA = sdA > 0 ? sdA + 1 : 1; } else { hiA = midA; chA = cntA; sdA = sdA < 0 ? sdA - 1 : -1; } }
        if (!dnB) { if (cntB == (unsigned)TOPK) { exB = true; thrB = midB; dnB = true; } else if (cntB > (unsigned)TOPK) { loB = midB; clB = (float)cntB; sdB = sdB > 0 ? sdB + 1 : 1; } else { hiB = midB; chB = cntB; sdB = sdB < 0 ? sdB - 1 : -1; } }
    }
#if ITER_PROBE
    if (lane == 0) atomicAdd((unsigned*)C.a->ws + 96, (unsigned)itp);
#endif
    unsigned needA = 0u, needB = 0u;
    if (!exA) { thrA = loA; needA = (unsigned)TOPK - chA; }
    if (!exB) { thrB = loB; needB = (unsigned)TOPK - chB; }
    const float tfA = __uint_as_float(unsortable(thrA)), tfB = __uint_as_float(unsortable(thrB));
    u64 mywA = 0ull, mywB = 0ull;
#pragma unroll
    for (int s = 0; s < NS; ++s) {
        u64 wA, wB;
        if (exA) wA = __ballot(fA[s] >= tfA);
        else { wA = __ballot(fA[s] > tfA); u64 eq = __ballot(fA[s] == tfA); const unsigned ce = (unsigned)__popcll(eq);
            if (ce <= needA) { wA |= eq; needA -= ce; } else { while (needA) { const u64 bit = eq & (0ull - eq); wA |= bit; eq ^= bit; --needA; } } }
        if (exB) wB = __ballot(fB[s] >= tfB);
        else { wB = __ballot(fB[s] > tfB); u64 eq = __ballot(fB[s] == tfB); const unsigned ce = (unsigned)__popcll(eq);
            if (ce <= needB) { wB |= eq; needB -= ce; } else { while (needB) { const u64 bit = eq & (0ull - eq); wB |= bit; eq ^= bit; --needB; } } }
        if (lane == s) { mywA = wA; mywB = wB; }
        __builtin_amdgcn_sched_barrier(0);
    }
    if (lane <= c) { mrowA[lane] = mywA; mrowB[lane] = mywB; }
}
#ifndef SEL_PAIR
#define SEL_PAIR 1
#endif
template <bool SCORE_F32> __device__ __forceinline__ void select_unit(Ctx& C, int b, int c, int g) {
    const int lane = C.lane, wid = C.wave, tid = C.tid;
    LAS float* sc = (LAS float*)C.lds;
    const int i0 = 64 * c + 16 * g, nkb = 4 * (c + 1);
    const bf16_t* P = WSP(bf16_t, WS_PROJ) + (size_t)b * TP * PC;
#pragma unroll 1
    for (int repA = 0; repA < SELA_REP; ++repA) {
    __syncthreads();
    if (SCORE_F32) {
        const float* X = WSP(float, WS_IDX) + (size_t)b * TP * 384;
        const int q = tid & 15; const float* qf = X + (size_t)(i0 + q) * 384;
        for (int e = tid >> 4; e < 64 * (c + 1); e += 32) { const float* kf = X + (size_t)e * 384 + 256; float tot = 0.f;
            for (int h = 0; h < 4; ++h) { float d = 0.f; for (int j = 0; j < 64; ++j) d += qf[h * 64 + j] * kf[j]; tot += qf[320 + h] * fmaxf(d, 0.f); }
            tot = tot + 0.f; if (e < 48) tot = -INFINITY; sc[q * SCP + e] = tot; }
    } else {
        const int query = lane & 15, kq = lane >> 4;
        const bf16_t* qrow = P + (size_t)(i0 + query) * PC;
        bf16x8 qf[4][2]; float w[4];
#pragma unroll
        for (int h = 0; h < 4; ++h) { qf[h][0] = *(const bf16x8*)(qrow + C_IQ + h * 64 + 8 * kq); qf[h][1] = *(const bf16x8*)(qrow + C_IQ + h * 64 + 32 + 8 * kq); w[h] = bf2f(qrow[C_IW + h]); }
        const bf16_t* kbase = P + (size_t)(lane & 15) * PC + C_IK + 8 * kq;
        bf16x8 ka[4][2], kn[4][2];
#define SEL_LOAD(dst, g) do { _Pragma("unroll") for (int u_ = 0; u_ < 4; ++u_) { const int kb_ = wid + 8 * (4 * (g) + u_); if (kb_ < nkb) { const bf16_t* kr_ = kbase + (size_t)(16 * kb_) * PC; dst[u_][0] = *(const bf16x8*)kr_; dst[u_][1] = *(const bf16x8*)(kr_ + 32); } } } while (0)
#define SEL_COMP(src, g) do { _Pragma("unroll") for (int u_ = 0; u_ < 4; ++u_) { const int kb_ = wid + 8 * (4 * (g) + u_); if (kb_ < nkb) { \
            f32x4 tot = (f32x4){0.f, 0.f, 0.f, 0.f}; \
            _Pragma("unroll") for (int h = 0; h < 4; ++h) { f32x4 acc = (f32x4){0.f, 0.f, 0.f, 0.f}; \
                acc = __builtin_amdgcn_mfma_f32_16x16x32_bf16(src[u_][0], qf[h][0], acc, 0, 0, 0); acc = __builtin_amdgcn_mfma_f32_16x16x32_bf16(src[u_][1], qf[h][1], acc, 0, 0, 0); \
                tot[0] += w[h] * fmaxf(acc[0], 0.f); tot[1] += w[h] * fmaxf(acc[1], 0.f); tot[2] += w[h] * fmaxf(acc[2], 0.f); tot[3] += w[h] * fmaxf(acc[3], 0.f); } \
            tot = tot + 0.f; \
            if (kb_ < 3) tot = (f32x4){-INFINITY, -INFINITY, -INFINITY, -INFINITY}; \
            *(LAS f32x4*)(sc + query * SCP + 16 * kb_ + 4 * kq) = tot; } } } while (0)
        const int ng = (nkb - wid + 31) >> 5;
        SEL_LOAD(ka, 0);
#pragma unroll 1
        for (int g = 0; g < ng; g += 2) {
            if (g + 1 < ng) SEL_LOAD(kn, g + 1);
            SEL_COMP(ka, g);
            if (g + 2 < ng) SEL_LOAD(ka, g + 2);
            if (g + 1 < ng) SEL_COMP(kn, g + 1);
        }
#undef SEL_LOAD
#undef SEL_COMP
    }
    }
    __syncthreads();
#if SEL_PAIR
    { const int qA = 2 * wid, qB = 2 * wid + 1; LAS float* scA = sc + qA * SCP; LAS float* scB = sc + qB * SCP;
      u64* mA = WSP(u64, WS_MASK) + ((size_t)b * TP + i0 + qA) * NTILE; u64* mB = mA + NTILE;
      if (c < 12) select_query2<12>(C, scA, scB, c, mA, mB); else if (c < 20) select_query2<20>(C, scA, scB, c, mA, mB); else if (c < 28) select_query2<28>(C, scA, scB, c, mA, mB); else select_query2<33>(C, scA, scB, c, mA, mB); }
#else
#pragma unroll 1
    for (int qq = 0; qq < SELB_N * SELB_REP; ++qq) {
        const int q = 2 * wid + (qq & 1); LAS float* scq = sc + q * SCP; u64* mrow = WSP(u64, WS_MASK) + ((size_t)b * TP + i0 + q) * NTILE;
        if (c < 12) select_query<12>(C, scq, c, mrow); else if (c < 20) select_query<20>(C, scq, c, mrow); else if (c < 28) select_query<28>(C, scq, c, mrow); else select_query<33>(C, scq, c, mrow);
    }
#endif
    __syncthreads();
}
template <bool SCORE_F32> __device__ __forceinline__ void phase_select_fast(Ctx& C, volatile LAS unsigned* MISC) {
    unsigned* qhead = (unsigned*)C.a->ws + CW_QSEL;
    const int NU = BATCH * (NTILE - 4) * 4;
    for (;;) {
        if (C.tid == 0) MISC[16] = atomicAdd(qhead, 1u);
        __syncthreads();
        const int j = (int)MISC[16];
        __syncthreads();
        if (j >= NU) break;
        const int c = 32 - (j >> 6), b = (j & 63) >> 2, g = j & 3;
        select_unit<SCORE_F32>(C, b, c, g);
    }
}
}
#ifndef FAST_SEL
#define FAST_SEL 1
#endif

#ifndef SEL_F32
#define SEL_F32 0
#endif
namespace fa {
typedef short bf16x8 __attribute__((ext_vector_type(8)));
typedef short s16x4 __attribute__((ext_vector_type(4)));
typedef float f32x16 __attribute__((ext_vector_type(16)));
typedef short v4i16_t __attribute__((ext_vector_type(4)));
typedef float f32x2_t __attribute__((ext_vector_type(2))); typedef __bf16 bf16x2_t __attribute__((ext_vector_type(2)));
constexpr int L_K = 0, L_V = 16384, L_WS = 32768, L_ST = 36864;
constexpr float NEGB = -1.0e30f;
constexpr float THR = 8.0f;
__device__ __forceinline__ int crow(int r, int hi) { return (r & 3) + 8 * (r >> 2) + 4 * hi; }
__device__ __forceinline__ void glds16(const void* gsrc, unsigned lds_dst) { unsigned keep;
    asm volatile("s_mov_b32 %0, m0\n\ts_mov_b32 m0, %2\n\ts_nop 0\n\tglobal_load_lds_dwordx4 %1, off\n\ts_mov_b32 m0, %0" : "=&s"(keep) : "v"(gsrc), "s"(lds_dst) : "memory"); }
__device__ __forceinline__ unsigned cvtpk(float lo, float hi) { f32x2_t v = {lo, hi}; bf16x2_t b = __builtin_convertvector(v, bf16x2_t); return __builtin_bit_cast(unsigned, b); }
__device__ __forceinline__ float half_swap_max(float m) { auto rr = __builtin_amdgcn_permlane32_swap(__float_as_uint(m), __float_as_uint(m), false, false); return fmaxf(__uint_as_float(rr[0]), __uint_as_float(rr[1])); }
__device__ __forceinline__ float half_swap_sum(float m) { auto rr = __builtin_amdgcn_permlane32_swap(__float_as_uint(m), __float_as_uint(m), false, false); return __uint_as_float(rr[0]) + __uint_as_float(rr[1]); }

__device__ __forceinline__ void attn_unit(Ctx& C, int b, int h, int tile0, int nq, int NT) {
    const int lane = C.lane, r32 = lane & 31, hi = lane >> 5, wid = C.wave;
    const int qt = tile0 + (wid >> 1); const bool active = (wid >> 1) < nq;
    const int i = qt * 64 + (wid & 1) * 32 + r32;
    const bf16_t* P = WSP(bf16_t, WS_PROJ) + (size_t)b * TP * PC;
    const unsigned lds0 = (unsigned)(size_t)C.lds;
    LAS float* wsf = (LAS float*)(C.lds + L_WS) + wid * 128;
    LAS float* stg = (LAS float*)(C.lds + L_ST) + wid * 2048;
    const bf16_t* ksrc = P + (size_t)lane * PC + C_AK + h * 64 + wid * 8;
    const bf16_t* vsrc = P + (size_t)(16 * (wid & 3) + (lane >> 2)) * PC + C_AV + h * 64 + (wid >> 2) * 32 + (lane & 3) * 8;
    const unsigned kdst = lds0 + L_K + wid * 1024, vdst = lds0 + L_V + wid * 1024;
#define FA_DMA(t, slot) do { glds16(ksrc + (size_t)(t) * 64 * PC, (unsigned)__builtin_amdgcn_readfirstlane(kdst + (slot) * 8192)); \
                             glds16(vsrc + (size_t)(t) * 64 * PC, (unsigned)__builtin_amdgcn_readfirstlane(vdst + (slot) * 8192)); } while (0)
    const float slope2 = exp2f(-(float)(h + 1)) * LOG2E;
    const float fi = (float)i;
    bf16x8 qr[4];
#pragma unroll
    for (int d0 = 0; d0 < 4; ++d0) qr[d0] = *(const bf16x8*)(P + (size_t)i * PC + C_AQ + h * 64 + d0 * 16 + hi * 8);
    const u64* mrow = WSP(u64, WS_MASK) + ((size_t)b * TP + i) * NTILE;
    float m_run = -INFINITY, l_run = 0.f;
    f32x16 o[2]; o[0] = f32x16{}; o[1] = f32x16{};
    FA_DMA(0, 0);
    u64 mw_next = mrow[0];
    for (int t = 0; t < NT; ++t) {
        const int slot = t & 1;
        asm volatile("s_waitcnt vmcnt(0) lgkmcnt(0)\n\ts_barrier" ::: "memory");
        const u64 mw = mw_next;
        if (t + 1 < NT) { mw_next = (t + 1 <= qt) ? mrow[t + 1] : 0ull; FA_DMA(t + 1, slot ^ 1); }
        if (active && t <= qt) {
            f32x16 p0 = f32x16{}, p1 = f32x16{};
            { const LAS char* kb = (const LAS char*)C.lds + L_K + slot * 8192 + hi * 1024 + r32 * 16;
#pragma unroll
              for (int d0 = 0; d0 < 4; ++d0) { const bf16x8 b0 = *(const LAS bf16x8*)(kb + d0 * 2048), b1 = *(const LAS bf16x8*)(kb + d0 * 2048 + 512);
                  p0 = __builtin_amdgcn_mfma_f32_32x32x16_bf16(b0, qr[d0], p0, 0, 0, 0); p1 = __builtin_amdgcn_mfma_f32_32x32x16_bf16(b1, qr[d0], p1, 0, 0, 0); } }
            const unsigned wl = (unsigned)mw >> (4 * hi), wh = (unsigned)(mw >> 32) >> (4 * hi);
            float A0, A1;
            if (t == qt) {
                const float kbase = (float)(64 * t + 4 * hi);
#pragma unroll
                for (int r = 0; r < 16; ++r) { const int kc = (r & 3) + 8 * (r >> 2); const float kf = kbase + (float)kc;
                    const float b0_ = slope2 * (fi - fabsf(fi - kf)), b1_ = slope2 * (fi - fabsf(fi - (kf + 32.f)));
                    p0[r] = ((wl >> kc) & 1u) ? p0[r] + b0_ : NEGB; p1[r] = ((wh >> kc) & 1u) ? p1[r] + b1_ : NEGB; }
                A0 = 0.f; A1 = 0.f;
            } else {
#pragma unroll
                for (int r = 0; r < 16; ++r) { const int kc = (r & 3) + 8 * (r >> 2); const float cr = slope2 * (float)kc;
                    p0[r] = ((wl >> kc) & 1u) ? p0[r] + cr : NEGB; p1[r] = ((wh >> kc) & 1u) ? p1[r] + cr : NEGB; }
                A0 = slope2 * (float)(64 * t + 4 * hi); A1 = A0 + 32.f * slope2;
            }
            float mx0 = p0[0], mx1 = p1[0];
#pragma unroll
            for (int r = 1; r < 16; ++r) { mx0 = fmaxf(mx0, p0[r]); mx1 = fmaxf(mx1, p1[r]); }
            const float rm = half_swap_max(fmaxf(mx0 + A0, mx1 + A1));
            const bool need = rm > m_run + THR;
            if (__any(need)) {
                const float mnew = need ? rm : m_run;
                const float alpha = need ? exp2f(m_run - mnew) : 1.f;
                m_run = mnew; l_run *= alpha;
                if (hi == 0) wsf[r32] = alpha;
                LDS_WAIT();
#pragma unroll
                for (int r = 0; r < 16; ++r) { const float a = wsf[crow(r, hi)]; o[0][r] *= a; o[1][r] *= a; }
            }
            const float s0 = m_run - A0, s1 = m_run - A1;
            float sum = 0.f;
#pragma unroll
            for (int r = 0; r < 16; ++r) { p0[r] = __builtin_amdgcn_exp2f(p0[r] - s0); p1[r] = __builtin_amdgcn_exp2f(p1[r] - s1); sum += p0[r] + p1[r]; }
            l_run += half_swap_sum(sum);
            u32x4 pw0, pw1, pw2, pw3;
            pw0 = (u32x4){cvtpk(p0[0], p0[1]), cvtpk(p0[2], p0[3]), cvtpk(p0[4], p0[5]), cvtpk(p0[6], p0[7])};
            pw1 = (u32x4){cvtpk(p0[8], p0[9]), cvtpk(p0[10], p0[11]), cvtpk(p0[12], p0[13]), cvtpk(p0[14], p0[15])};
            pw2 = (u32x4){cvtpk(p1[0], p1[1]), cvtpk(p1[2], p1[3]), cvtpk(p1[4], p1[5]), cvtpk(p1[6], p1[7])};
            pw3 = (u32x4){cvtpk(p1[8], p1[9]), cvtpk(p1[10], p1[11]), cvtpk(p1[12], p1[13]), cvtpk(p1[14], p1[15])};
            const int vb = (int)(lds0 + L_V + slot * 8192) + ((lane >> 4) & 1) * 32 + (lane & 3) * 8 + (4 * hi + ((lane & 15) >> 2)) * 64;
#pragma unroll
            for (int d0 = 0; d0 < 2; ++d0) { s16x4 lo_[4], hi_[4];
#pragma unroll
                for (int ks = 0; ks < 4; ++ks) {
                    asm volatile("ds_read_b64_tr_b16 %0,%1 offset:%c2" : "=&v"(lo_[ks]) : "v"(vb), "i"(d0 * 4096 + ks * 1024) : "memory");
                    asm volatile("ds_read_b64_tr_b16 %0,%1 offset:%c2" : "=&v"(hi_[ks]) : "v"(vb), "i"(d0 * 4096 + ks * 1024 + 512) : "memory"); }
                asm volatile("s_waitcnt lgkmcnt(0)" ::: "memory"); __builtin_amdgcn_sched_barrier(0);
#define FA_PK(k) (bf16x8){lo_[k][0], lo_[k][1], lo_[k][2], lo_[k][3], hi_[k][0], hi_[k][1], hi_[k][2], hi_[k][3]}
                o[d0] = __builtin_amdgcn_mfma_f32_32x32x16_bf16(__builtin_bit_cast(bf16x8, pw0), FA_PK(0), o[d0], 0, 0, 0);
                o[d0] = __builtin_amdgcn_mfma_f32_32x32x16_bf16(__builtin_bit_cast(bf16x8, pw1), FA_PK(1), o[d0], 0, 0, 0);
                o[d0] = __builtin_amdgcn_mfma_f32_32x32x16_bf16(__builtin_bit_cast(bf16x8, pw2), FA_PK(2), o[d0], 0, 0, 0);
                o[d0] = __builtin_amdgcn_mfma_f32_32x32x16_bf16(__builtin_bit_cast(bf16x8, pw3), FA_PK(3), o[d0], 0, 0, 0);
#undef FA_PK
            }
        }
    }
    if (active) {
        if (hi == 0) wsf[32 + r32] = l_run;
        LDS_WAIT();
#pragma unroll
        for (int r = 0; r < 16; ++r) { const int orow = crow(r, hi); const float rl = 1.f / wsf[32 + orow];
            stg[orow * 64 + r32] = o[0][r] * rl; stg[orow * 64 + 32 + r32] = o[1][r] * rl; }
        LDS_WAIT();
        const float* gain = IN_(7) + h * 64;
#pragma unroll
        for (int it = 0; it < 4; ++it) { const int row = it * 8 + (lane >> 3), ch = lane & 7;
            const f32x4 v0 = *(const LAS f32x4*)(stg + row * 64 + ch * 8), v1 = *(const LAS f32x4*)(stg + row * 64 + ch * 8 + 4);
            float ss = (v0[0] * v0[0] + v0[1] * v0[1]) + (v0[2] * v0[2] + v0[3] * v0[3]) + (v1[0] * v1[0] + v1[1] * v1[1]) + (v1[2] * v1[2] + v1[3] * v1[3]);
            ss += __shfl_xor(ss, 1); ss += __shfl_xor(ss, 2); ss += __shfl_xor(ss, 4);
            const float rstd = 1.f / sqrtf(ss * (1.f / 64.f) + 1e-6f);
            const f32x4 g0 = *(const f32x4*)(gain + ch * 8), g1 = *(const f32x4*)(gain + ch * 8 + 4);
            const float w[8] = {v0[0] * rstd * g0[0], v0[1] * rstd * g0[1], v0[2] * rstd * g0[2], v0[3] * rstd * g0[3], v1[0] * rstd * g1[0], v1[1] * rstd * g1[1], v1[2] * rstd * g1[2], v1[3] * rstd * g1[3]};
            const int ii = qt * 64 + (wid & 1) * 32 + row;
            if (ii >= 64) { if (USE_FP8) store8_f8(WSP(unsigned char, WS_MIX8) + ((size_t)b * SEQ + (ii - 64)) * DM + h * 64 + ch * 8, w, 16.f); else store8_mix(WSP(bf16_t, WS_MIXED) + ((size_t)b * SEQ + (ii - 64)) * DM + h * 64 + ch * 8, w); }
            else if (ii >= 48) store8_bf16(WSP(bf16_t, WS_MIXM) + ((size_t)b * 16 + (ii - 48)) * DM + h * 64 + ch * 8, w);
        }
    }
    asm volatile("s_waitcnt vmcnt(0) lgkmcnt(0)\n\ts_barrier" ::: "memory");
#undef FA_DMA
}
__device__ __forceinline__ void phase_attn_fast(Ctx& C) {
    const int vcu = (C.G % 8 == 0) ? (C.bid % 8) * (C.G / 8) + C.bid / 8 : C.bid;
    for (int w = vcu; w < 256; w += C.G) {
        const int bh = w >> 1, par = w & 1, b = bh >> 3, h = bh & 7;
#pragma unroll 1
        for (int k = 0; k < 5; ++k) {
            if (k == 4 && par != 0) continue;
            const int u = (k == 0) ? (par ? 6 : 7) : (k == 1) ? (par ? 1 : 0) : (k == 2) ? (par ? 4 : 5) : (par ? 3 : 2);
            const int tile0 = (k == 4) ? 0 : 4 * u + 1, nq = (k == 4) ? 1 : 4, NT = (k == 4) ? 1 : 4 * u + 5;
            attn_unit(C, b, h, tile0, nq, NT);
        }
    }
    __syncthreads();
}
}
#ifndef FAST_ATTN
#define FAST_ATTN 1
#endif
__device__ __forceinline__ void job_y1m(Ctx& C) {
    const int gt = C.bid * NTHR + C.tid;
    if (gt < 2 * DM) { const int r = gt >> 10, n = gt & 1023; const bf16_t* mr = WSP(bf16_t, WS_MIXM) + (size_t)(14 + r) * DM; float acc = 0.f;
        for (int k = 0; k < DM; ++k) acc += bf2f(mr[k]) * IN_(9)[(size_t)k * DM + n];
        WSP(float, WS_Y1M)[r * DM + n] = ALPHA * WSP(float, WS_H0M)[(14 + r) * DM + n] + acc; }
}
__device__ __forceinline__ void job_ameta(Ctx& C) {
    const int gt = C.bid * NTHR + C.tid;
    if (gt < 2 * DFF) { const int r = gt / DFF, n = gt % DFF; const bf16_t* wr = WSP(bf16_t, WS_WUP) + (size_t)((n >> 7) * 256 + (n & 127)) * DM; const float* hr = WSP(float, WS_H1M) + r * DM; float acc = 0.f;
        for (int k = 0; k < DM; ++k) acc += hr[k] * bf2f(wr[k]);
        WSP(float, WS_AMETA)[r * DFF + n] = acc; }
}
__device__ __forceinline__ float gelu_tanh(float x) { const float u = 0.7978845608028654f * (x + 0.044715f * x * x * x); return 0.5f * x * (1.f + tanhf(u)); }
__device__ __forceinline__ void phase_conv(Ctx& C, int half) {
    const int gt = C.bid * NTHR + C.tid, NGT = C.G * NTHR;
    for (int it = gt; it < MR * 11 * 16; it += NGT) {
        const int r8 = it & 15, jj = (it >> 4) % 11, m = it / (16 * 11), s = m & 2047;
        const int na = (half * 11 + jj) * 128 + r8 * 8;
        const bf16_t* up = WSP(bf16_t, WS_U) + (size_t)m * DFF + jj * 256 + r8 * 8;
        const u32x4 a0 = *(const u32x4*)up, g0 = *(const u32x4*)(up + 128);
        float a[8], a1[8], a2[8], g[8];
        a[0] = bflo(a0.x); a[1] = bfhi(a0.x); a[2] = bflo(a0.y); a[3] = bfhi(a0.y); a[4] = bflo(a0.z); a[5] = bfhi(a0.z); a[6] = bflo(a0.w); a[7] = bfhi(a0.w);
        g[0] = bflo(g0.x); g[1] = bfhi(g0.x); g[2] = bflo(g0.y); g[3] = bfhi(g0.y); g[4] = bflo(g0.z); g[5] = bfhi(g0.z); g[6] = bflo(g0.w); g[7] = bfhi(g0.w);
        if (s >= 1) { const u32x4 t = *(const u32x4*)(up - DFF); a1[0] = bflo(t.x); a1[1] = bfhi(t.x); a1[2] = bflo(t.y); a1[3] = bfhi(t.y); a1[4] = bflo(t.z); a1[5] = bfhi(t.z); a1[6] = bflo(t.w); a1[7] = bfhi(t.w); }
        else {
#pragma unroll
            for (int j = 0; j < 8; ++j) a1[j] = WSP(float, WS_AMETA)[DFF + na + j]; }
        if (s >= 2) { const u32x4 t = *(const u32x4*)(up - 2 * DFF); a2[0] = bflo(t.x); a2[1] = bfhi(t.x); a2[2] = bflo(t.y); a2[3] = bfhi(t.y); a2[4] = bflo(t.z); a2[5] = bfhi(t.z); a2[6] = bflo(t.w); a2[7] = bfhi(t.w); }
        else {
#pragma unroll
            for (int j = 0; j < 8; ++j) a2[j] = WSP(float, WS_AMETA)[(s == 1 ? DFF : 0) + na + j]; }
        float o[8];
#pragma unroll
        for (int j = 0; j < 8; ++j) { const float cv = a2[j] * IN_(13)[na + j] + a1[j] * IN_(13)[DFF + na + j] + a[j] * IN_(13)[2 * DFF + na + j] + IN_(14)[na + j]; o[j] = gelu_tanh(cv) * g[j]; }
        store8_bf16(WSP(bf16_t, WS_ACT) + (size_t)m * DFF + na, o);
    }
}


#ifndef MB_KIND
#define MB_KIND 0
#endif
#ifndef MB_ITERS
#define MB_ITERS 2000
#endif
__device__ __forceinline__ void microbench(Ctx& C) {
#if MB_KIND == 1
    float f[33];
#pragma unroll
    for (int s = 0; s < 33; ++s) f[s] = (float)(C.tid * 33 + s) * 0.001f;
    unsigned a0 = 0, a1 = 0; float t = 0.5f;
#pragma unroll 1
    for (int it = 0; it < MB_ITERS; ++it) {
#pragma unroll
        for (int s = 0; s < 33; ++s) { const unsigned i = __float_as_uint(f[s] - t) >> 31; if (s & 1) a1 += i; else a0 += i; }
        t += 0.001f; asm volatile("" : "+v"(t));
    }
    if (a0 + a1 == 0x12345678u) WSP(unsigned, WS_CTL)[200] = a0;
#elif MB_KIND == 2
    if (C.wave < 4) {
    float f[33];
#pragma unroll
    for (int s = 0; s < 33; ++s) f[s] = (float)(C.tid * 33 + s) * 0.001f;
    unsigned a0 = 0, a1 = 0; float t = 0.5f;
#pragma unroll 1
    for (int it = 0; it < MB_ITERS; ++it) {
#pragma unroll
        for (int s = 0; s < 33; ++s) { const unsigned i = __float_as_uint(f[s] - t) >> 31; if (s & 1) a1 += i; else a0 += i; }
        t += 0.001f; asm volatile("" : "+v"(t));
    }
    if (a0 + a1 == 0x12345678u) WSP(unsigned, WS_CTL)[200] = a0;
    }
#elif MB_KIND == 3
    float f[33];
#pragma unroll
    for (int s = 0; s < 33; ++s) f[s] = (float)(C.tid * 33 + s) * 0.001f;
    float t = 0.5f;
#pragma unroll 1
    for (int it = 0; it < MB_ITERS; ++it) {
#pragma unroll
        for (int s = 0; s < 33; ++s) { f[s] = f[s] * t + 0.25f; f[s] = f[s] * t + 0.125f; f[s] = f[s] * t + 0.0625f; }
        asm volatile("" : "+v"(t));
    }
    float sum = 0.f;
#pragma unroll
    for (int s = 0; s < 33; ++s) sum += f[s];
    if (sum == 1234.5f) WSP(unsigned, WS_CTL)[200] = 1u;
#endif
}
constexpr int LDS_BYTES = 147456;
constexpr int MISC_OFF = 147456 - 256;
constexpr int N_PHASES = 13;

__global__ void __launch_bounds__(NTHR, 2) fwd_kernel(Args args) {
    extern __shared__ __attribute__((aligned(16))) unsigned char lds[];
    Ctx C;
    C.lds = (LAS unsigned char*)lds;
    C.tid = threadIdx.x; C.lane = C.tid & 63; C.wave = __builtin_amdgcn_readfirstlane(C.tid >> 6); C.bid = blockIdx.x; C.G = gridDim.x;
    unsigned char* ws = args.ws; C.a = &args;
    volatile LAS unsigned* MISC = (volatile LAS unsigned*)(C.lds + MISC_OFF);
    if (C.tid < 32) MISC[C.tid] = 0u;
    __syncthreads();
    XcdBarrier bar = xcd_barrier_post((unsigned*)(ws + WS_CTL) + CW_BAR, MISC + 8);
    const int lo = args.ph_lo, hi = args.ph_hi;
#ifndef PHMASK
#define PHMASK 0xFFFFFFFFu
#endif
#define IN(k) (((PHMASK >> (k)) & 1u) && lo <= (k) && (k) < hi)
#ifndef TIME_PHASE
#define TIME_PHASE -1
#endif
#ifndef TSCALE
#define TSCALE 0.02f
#endif
    unsigned long long tp0 = (TIME_PHASE == 0) ? __builtin_amdgcn_s_memrealtime() : 0ull, tp1 = 0ull;
#define SEAM(k) do { if (IN(k) && IN((k) + 1)) xcd_barrier(bar); if (TIME_PHASE >= 0 && (((k) + 1 == TIME_PHASE && TIME_PHASE != 8) || ((k) == 7 && TIME_PHASE == 11) || ((k) == 3 && TIME_PHASE == 8))) tp0 = __builtin_amdgcn_s_memrealtime(); if (TIME_PHASE >= 0 && (k) == TIME_PHASE) tp1 = __builtin_amdgcn_s_memrealtime(); } while (0)
    const int gw = C.bid * NWAVES + C.wave, NGW = C.G * NWAVES;

    if (MB_KIND != 0) microbench(C);
    if (IN(0)) { phase_prologue(C); } SEAM(0);
#if PROBE_F32IDX
    if (IN(1)) { phase_meta(C); } SEAM(1);
#endif
    if (IN(2)) {
#if USE_FP8
        { EpiProj E{WSP(bf16_t, WS_PROJ), C_SPLIT}; fast_gemm(C, WSP(bf16_t, WS_H0), WSP(bf16_t, WS_WINB), MR, PC - C_SPLIT, DM, E); }
        { EpiProj E{WSP(bf16_t, WS_PROJ), 0}; fast_gemm_f8<EpiProj, E_A16>(C, WSP(unsigned char, WS_H0Q), WSP(unsigned char, WS_WIN8), MR, C_SPLIT, DM, E); }
#elif EMU_FP8_IN
        { EpiProj E{WSP(bf16_t, WS_PROJ), 0}; fast_gemm(C, WSP(bf16_t, WS_H0Q), WSP(bf16_t, WS_WIN), MR, C_SPLIT, DM, E); }
        { EpiProj E{WSP(bf16_t, WS_PROJ), C_SPLIT}; fast_gemm(C, WSP(bf16_t, WS_H0), WSP(bf16_t, WS_WIN) + (size_t)C_SPLIT * DM, MR, PC - C_SPLIT, DM, E); }
#else
        EpiProj E{WSP(bf16_t, WS_PROJ), 0}; GEMM_CALL(C, WSP(bf16_t, WS_H0), WSP(bf16_t, WS_WIN), MR, PC, DM, E);
#endif
#if PROBE_F32IDX
        naive_idx_gemm(C);
#endif
    } SEAM(2);
    if (IN(3)) {
#if !defined(NO_GLA) && !GLA_SEP
#if FAST_GLA
        for (int un = C.bid; un < BATCH * 4; un += C.G) gla::gla_unit(C, un >> 2, un & 3);
#else
        for (int un = C.bid; un < BATCH * 4; un += C.G) gla_naive_unit(C, un >> 2, un & 3);
#endif
#endif
#ifndef NO_SEL
#if FAST_SEL
        sel::phase_select_fast<SEL_F32 != 0>(C, MISC);
#else
        phase_select_naive(C);
#endif
#endif
    } SEAM(3);
#if GLA_SEP
    if (IN(8)) { for (int un = C.bid; un < BATCH * 4; un += C.G) gla::gla_unit(C, un >> 2, un & 3); } SEAM(8);
#endif
#if FAST_ATTN
    if (IN(4)) { fa::phase_attn_fast(C); } SEAM(4);
#else
    if (IN(4)) { phase_attn_naive(C); } SEAM(4);
#endif
#if FUSE_LN && USE_FP8
    if (IN(5)) { job_y1m_f8(C); EpiYB E{WSP(bf16_t, WS_Y1B), WSP(bf16_t, WS_H0)}; fast_gemm_f8<EpiYB, E_A16>(C, WSP(unsigned char, WS_MIX8), WSP(unsigned char, WS_WOUT8), MR, DM, DM, E); } SEAM(5);
    if (IN(6)) { for (int m = gw; m < MR + 2; m += NGW) { if (m < MR) ln_row_b<true>(WSP(bf16_t, WS_Y1B) + (size_t)m * DM, IN_(10), IN_(11), WSP(bf16_t, WS_H1) + (size_t)m * DM, C.lane, (bf16_t*)(WSP(unsigned char, WS_H1Q) + (size_t)m * DM));
                                                           else ln_row<false>(WSP(float, WS_Y1M) + (size_t)(m - MR) * DM, IN_(10), IN_(11), WSP(float, WS_H1M) + (size_t)(m - MR) * DM, C.lane); } } SEAM(6);
    if (IN(7)) { job_ameta_f8(C);
        pg8::Gemm g{(const bf16_t*)WSP(unsigned char, WS_H1Q), (const bf16_t*)WSP(unsigned char, WS_WUP8), MR, NUP, DM / 2}; pg8::StaticOrder S; S.init(MR, NUP, C.G, C.bid);
        EpiUpConv E{(bf16_t*)WSP(unsigned char, WS_ACT8), WSP(float, WS_FIX), WSP(float, WS_HALO), IN_(13), IN_(14), (LAS float*)(C.lds + 131072), nullptr, nullptr};
        pg8::gemm_phase<EpiUpConv, pg8::StaticOrder, true, true, true, E_W, E_A16>((PG8_LAS unsigned char*)C.lds, g, S, E); __syncthreads(); } SEAM(7);
    if (IN(11)) { { pg8::StaticOrder S; S.init(MR, DM, C.G, C.bid); pg8::Unit u; for (int i = 0; S.next(i, u); ++i) fix_rows(C, u.pm); }
        asm volatile("s_waitcnt vmcnt(0)" ::: "memory"); __syncthreads();
        EpiYB E{WSP(bf16_t, WS_Y2B), WSP(bf16_t, WS_H1)}; fast_gemm_f8<EpiYB, E_A8>(C, WSP(unsigned char, WS_ACT8), WSP(unsigned char, WS_WDN8), MR, DM, DFF, E); } SEAM(11);
    if (IN(12)) { for (int m = gw; m < MR; m += NGW) ln_row_b<false>(WSP(bf16_t, WS_Y2B) + (size_t)m * DM, IN_(16), IN_(17), C.a->out + (size_t)m * DM, C.lane); }
#elif FUSE_LN
    if (IN(5)) { job_y1m_fast(C); EpiYB E{WSP(bf16_t, WS_Y1B), WSP(bf16_t, WS_H0)}; fast_gemm(C, WSP(bf16_t, WS_MIXED), WSP(bf16_t, WS_WOUT), MR, DM, DM, E); } SEAM(5);
    if (IN(6)) { for (int m = gw; m < MR + 2; m += NGW) { if (m < MR) ln_row_b<true>(WSP(bf16_t, WS_Y1B) + (size_t)m * DM, IN_(10), IN_(11), WSP(bf16_t, WS_H1) + (size_t)m * DM, C.lane, WSP(bf16_t, WS_Y1B) + (size_t)m * DM);
                                                           else ln_row<false>(WSP(float, WS_Y1M) + (size_t)(m - MR) * DM, IN_(10), IN_(11), WSP(float, WS_H1M) + (size_t)(m - MR) * DM, C.lane); } } SEAM(6);
    if (IN(7)) { job_ameta_fast2(C);
        pg8::Gemm g{EMU_FP8 ? WSP(bf16_t, WS_Y1B) : WSP(bf16_t, WS_H1), WSP(bf16_t, WS_WUP), MR, NUP, DM}; pg8::StaticOrder S; S.init(MR, NUP, C.G, C.bid);
        EpiUpConv E{WSP(bf16_t, WS_ACT), WSP(float, WS_FIX), WSP(float, WS_HALO), IN_(13), IN_(14), (LAS float*)(C.lds + 131072), nullptr, nullptr};
        pg8::gemm_phase<EpiUpConv, pg8::StaticOrder, true, true>((PG8_LAS unsigned char*)C.lds, g, S, E); __syncthreads(); } SEAM(7);
    if (IN(11)) { { pg8::StaticOrder S; S.init(MR, DM, C.G, C.bid); pg8::Unit u; for (int i = 0; S.next(i, u); ++i) fix_rows(C, u.pm); }
        asm volatile("s_waitcnt vmcnt(0)" ::: "memory"); __syncthreads();
        EpiYB E{WSP(bf16_t, WS_Y2B), WSP(bf16_t, WS_H1)}; fast_gemm(C, WSP(bf16_t, WS_ACT), WSP(bf16_t, WS_WDN), MR, DM, DFF, E); } SEAM(11);
    if (IN(12)) { for (int m = gw; m < MR; m += NGW) ln_row_b<false>(WSP(bf16_t, WS_Y2B) + (size_t)m * DM, IN_(16), IN_(17), C.a->out + (size_t)m * DM, C.lane); }
#else
    if (IN(5)) { job_y1m(C); EpiY E{WSP(float, WS_Y1), WSP(bf16_t, WS_H0)}; GEMM_CALL(C, WSP(bf16_t, WS_MIXED), WSP(bf16_t, WS_WOUT), MR, DM, DM, E); } SEAM(5);
    if (IN(6)) { for (int m = gw; m < MR + 2; m += NGW) { if (m < MR) ln_row<true>(WSP(float, WS_Y1) + (size_t)m * DM, IN_(10), IN_(11), WSP(bf16_t, WS_H1) + (size_t)m * DM, C.lane);
                                                           else ln_row<false>(WSP(float, WS_Y1M) + (size_t)(m - MR) * DM, IN_(10), IN_(11), WSP(float, WS_H1M) + (size_t)(m - MR) * DM, C.lane); } } SEAM(6);
#if FUSE_CONV
    if (IN(7)) { job_ameta(C);
        pg8::Gemm g{WSP(bf16_t, WS_H1), WSP(bf16_t, WS_WUP), MR, NUP, DM}; pg8::StaticOrder S; S.init(MR, NUP, C.G, C.bid);
        EpiUpConv E{WSP(bf16_t, WS_ACT), WSP(float, WS_FIX), WSP(float, WS_HALO), IN_(13), IN_(14), (LAS float*)(C.lds + 131072), nullptr, nullptr};
        pg8::gemm_phase<EpiUpConv, pg8::StaticOrder, true, true>((PG8_LAS unsigned char*)C.lds, g, S, E); __syncthreads(); } SEAM(7);
    if (IN(11)) { { pg8::StaticOrder S; S.init(MR, DM, C.G, C.bid); pg8::Unit u; for (int i = 0; S.next(i, u); ++i) fix_rows(C, u.pm); }
        asm volatile("s_waitcnt vmcnt(0)" ::: "memory"); __syncthreads();
        EpiY E{WSP(float, WS_Y2), WSP(bf16_t, WS_H1)}; GEMM_CALL(C, WSP(bf16_t, WS_ACT), WSP(bf16_t, WS_WDN), MR, DM, DFF, E); } SEAM(11);
#else
    if (IN(7)) { job_ameta(C); EpiU E{WSP(bf16_t, WS_U)}; GEMM_CALL(C, WSP(bf16_t, WS_H1), WSP(bf16_t, WS_WUP), MR, DFF, DM, E); } SEAM(7);
    if (IN(8)) { phase_conv(C, 0); } SEAM(8);
    if (IN(9)) { EpiU E{WSP(bf16_t, WS_U)}; GEMM_CALL(C, WSP(bf16_t, WS_H1), WSP(bf16_t, WS_WUP) + (size_t)DFF * DM, MR, DFF, DM, E); } SEAM(9);
    if (IN(10)) { phase_conv(C, 1); } SEAM(10);
    if (IN(11)) { EpiY E{WSP(float, WS_Y2), WSP(bf16_t, WS_H1)}; GEMM_CALL(C, WSP(bf16_t, WS_ACT), WSP(bf16_t, WS_WDN), MR, DM, DFF, E); } SEAM(11);
#endif
    if (IN(12)) { for (int m = gw; m < MR; m += NGW) ln_row<false>(WSP(float, WS_Y2) + (size_t)m * DM, IN_(16), IN_(17), (C.a->out) + (size_t)m * DM, C.lane); }
#endif
#if ITER_PROBE
    if (C.bid == 0 && C.tid == 0) { asm volatile("s_waitcnt vmcnt(0)" ::: "memory"); C.a->out[0] += 0.5f * (float)(*((volatile unsigned*)C.a->ws + 96)) / 29696.f; }
#endif
    if (TIME_PHASE >= 0) { if (TIME_PHASE == 12) tp1 = __builtin_amdgcn_s_memrealtime(); if (C.bid == 0 && C.tid == 0) { asm volatile("s_waitcnt vmcnt(0)" ::: "memory"); C.a->out[0] += TSCALE * 0.01f * (float)(tp1 - tp0); } }
#undef IN
#undef SEAM
}

#ifndef MK_SPLIT
#define MK_SPLIT 0
#endif
extern "C" void kernel_launch(void* const* d_in, const int* in_sizes, int n_in, void* d_out, int out_size, void* d_ws, size_t ws_size, hipStream_t stream) {
    static int grid = 0;
    if (grid == 0) {
        if (n_in != 18 || out_size != MR * DM || ws_size < WS_END) { fprintf(stderr, "kernel_launch: unexpected problem (n_in %d out %d ws %zu)\n", n_in, out_size, ws_size); grid = -1; return; }
        int dev = 0, cus = 0;
        if (hipGetDevice(&dev) != hipSuccess || hipDeviceGetAttribute(&cus, hipDeviceAttributeMultiprocessorCount, dev) != hipSuccess) { grid = -1; return; }
        if (hipFuncSetAttribute((const void*)fwd_kernel, hipFuncAttributeMaxDynamicSharedMemorySize, LDS_BYTES) != hipSuccess) { fprintf(stderr, "kernel_launch: hipFuncSetAttribute failed\n"); grid = -1; return; }
        int per_cu = 0;
        if (hipOccupancyMaxActiveBlocksPerMultiprocessor(&per_cu, (const void*)fwd_kernel, NTHR, LDS_BYTES) != hipSuccess || per_cu < 1) fprintf(stderr, "kernel_launch: occupancy query says %d\n", per_cu);
        (void)hipGetLastError();
        grid = cus;
    }
    if (grid < 0) return;
    (void)hipMemsetAsync((char*)d_ws + WS_CTL, 0, CTL_ZERO_BYTES, stream);
    Args a{};
    for (int i = 0; i < 18; ++i) a.in[i] = (const float*)d_in[i];
    a.out = (float*)d_out; a.ws = (unsigned char*)d_ws;
#if MK_SPLIT
    for (int p = 0; p < N_PHASES; ++p) { a.ph_lo = p; a.ph_hi = p + 1; hipLaunchKernelGGL(fwd_kernel, dim3(grid), dim3(NTHR), LDS_BYTES, stream, a); }
#else
    a.ph_lo = 0; a.ph_hi = N_PHASES;
    hipLaunchKernelGGL(fwd_kernel, dim3(grid), dim3(NTHR), LDS_BYTES, stream, a);
#endif
}
```
